# Optimizing an MI355X kernel written in HIP

```python
import math
import jax, jax.numpy as jnp
from jax import lax
import numpy as np

D_MODEL = 2048
BATCH = 4
SEQ = 4096
DEPTH = 4

GRID_W = 64
N_MIXERS = 2
BLOCK_Q = 128
CHUNK = 128
ROPE_THETA = 10000.0
RMS_EPS = 1e-6
LN_EPS = 1e-5

A_HEADS = 16
A_KV_HEADS = 4
A_HEAD_DIM = D_MODEL // A_HEADS
A_GROUP = A_HEADS // A_KV_HEADS
A_WIDTH = A_HEADS * A_HEAD_DIM
A_KV_WIDTH = A_KV_HEADS * A_HEAD_DIM
A_IN = 2 * A_WIDTH + 2 * A_KV_WIDTH

R_HEADS = 8
R_QK_DIM = D_MODEL // R_HEADS
R_V_DIM = 2 * R_QK_DIM
R_QK_WIDTH = R_HEADS * R_QK_DIM
R_V_WIDTH = R_HEADS * R_V_DIM
R_IN = 2 * R_QK_WIDTH + 2 * R_V_WIDTH
R_DECAY_BASE = 5.0

N_A_LAYERS = (DEPTH + 1) // N_MIXERS
N_R_LAYERS = DEPTH // N_MIXERS
ALPHA = (2.0 * DEPTH) ** 0.25
BETA = (8.0 * DEPTH) ** -0.25

kernel_name = "hybrid_gqa_retention_deepnorm_encoder"


def axial_rope_tables(seq_len, head_dim):
    rows_n = seq_len // GRID_W
    row = jnp.repeat(jnp.arange(rows_n, dtype=jnp.float32), GRID_W)
    col = jnp.tile(jnp.arange(GRID_W, dtype=jnp.float32), rows_n)
    half = head_dim // 2
    inv_freq = ROPE_THETA ** (-jnp.arange(0, half, 2, dtype=jnp.float32) / half)
    ang_r = row[:, None] * inv_freq
    ang_c = col[:, None] * inv_freq
    ang = jnp.concatenate([ang_r, ang_r, ang_c, ang_c], axis=-1)
    return jnp.cos(ang), jnp.sin(ang)


def apply_rope(x, cos, sin):
    x32 = x.astype(jnp.float32)
    a, b, c, d = jnp.split(x32, 4, axis=-1)
    rot = jnp.concatenate([-b, a, -d, c], axis=-1)
    out = x32 * cos[None, :, None, :] + rot * sin[None, :, None, :]
    return out.astype(x.dtype)


def rms_norm(x, gain):
    x32 = x.astype(jnp.float32)
    y = x32 * lax.rsqrt(jnp.mean(x32 * x32, axis=-1, keepdims=True) + RMS_EPS)
    return (y * gain.astype(jnp.float32)).astype(x.dtype)


def layer_norm(x, gain, bias):
    x32 = x.astype(jnp.float32)
    mu = jnp.mean(x32, axis=-1, keepdims=True)
    var = jnp.mean(jnp.square(x32 - mu), axis=-1, keepdims=True)
    y = (x32 - mu) * lax.rsqrt(var + LN_EPS)
    return (y * gain.astype(jnp.float32) + bias.astype(jnp.float32)).astype(x.dtype)


def head_group_norm(x):
    x32 = x.astype(jnp.float32)
    mu = jnp.mean(x32, axis=-1, keepdims=True)
    var = jnp.mean(jnp.square(x32 - mu), axis=-1, keepdims=True)
    return ((x32 - mu) * lax.rsqrt(var + LN_EPS)).astype(x.dtype)


def attention_mixer(h, w_in, q_gain, k_gain, w_out, cos, sin):
    B, S, _ = h.shape
    proj = h @ w_in
    q, k, v, g = jnp.split(proj, [A_WIDTH, A_WIDTH + A_KV_WIDTH, A_WIDTH + 2 * A_KV_WIDTH], axis=-1)
    q = q.reshape(B, S, A_HEADS, A_HEAD_DIM)
    k = k.reshape(B, S, A_KV_HEADS, A_HEAD_DIM)
    v = v.reshape(B, S, A_KV_HEADS, A_HEAD_DIM)
    q = apply_rope(rms_norm(q, q_gain), cos, sin) * (A_HEAD_DIM ** -0.5)
    k = apply_rope(rms_norm(k, k_gain), cos, sin)
    n_blocks = S // BLOCK_Q
    qb_all = q.reshape(B, n_blocks, BLOCK_Q, A_KV_HEADS, A_GROUP, A_HEAD_DIM).transpose(1, 0, 3, 4, 2, 5)

    def block(qb):
        s = jnp.einsum('bkgqd,bskd->bkgqs', qb, k).astype(jnp.float32)
        p = jax.nn.softmax(s, axis=-1).astype(v.dtype)
        return jnp.einsum('bkgqs,bskd->bkgqd', p, v)

    o = lax.map(block, qb_all)
    o = o.transpose(1, 0, 4, 2, 3, 5).reshape(B, S, A_WIDTH)
    return (o * jax.nn.silu(g)) @ w_out


def chunk_retention(q, k, v, log_g, strict):
    B, S, H, dk = q.shape
    dv = v.shape[-1]
    nc = S // CHUNK

    def to_chunks(t):
        return t.reshape(B, nc, CHUNK, H, t.shape[-1]).transpose(1, 0, 3, 2, 4)

    qc, kc, vc = to_chunks(q), to_chunks(k), to_chunks(v)
    log_g = log_g.astype(jnp.float32)
    pos = jnp.arange(CHUNK, dtype=jnp.float32)
    diff = pos[:, None] - pos[None, :]
    mask = (diff > 0) if strict else (diff >= 0)
    intra_decay = jnp.where(mask[None], jnp.exp(log_g[:, None, None] * jnp.maximum(diff, 0.0)[None]), 0.0)
    q_decay = jnp.exp(log_g[:, None] * (pos + 1.0))[..., None]
    k_decay = jnp.exp(log_g[:, None] * (CHUNK - 1.0 - pos))[..., None]
    chunk_decay = jnp.exp(log_g * CHUNK)[:, None, None]

    def step(state, xs):
        qb, kb, vb = xs
        q32, k32, v32 = qb.astype(jnp.float32), kb.astype(jnp.float32), vb.astype(jnp.float32)
        s = jnp.einsum('bhqd,bhkd->bhqk', q32, k32) * intra_decay
        inner = jnp.einsum('bhqk,bhkv->bhqv', s, v32)
        cross = jnp.einsum('bhqd,bhdv->bhqv', q32, state) * q_decay
        new_state = state * chunk_decay + jnp.einsum('bhkd,bhkv->bhdv', k32 * k_decay, v32)
        return new_state, (inner + cross).astype(vb.dtype)

    state0 = jnp.zeros((B, H, dk, dv), jnp.float32)
    _, out = lax.scan(step, state0, (qc, kc, vc))
    return out.transpose(1, 0, 3, 2, 4).reshape(B, S, H, dv)


def retention_mixer(h, w_in, decay_exp, w_out, cos, sin):
    B, S, _ = h.shape
    proj = h @ w_in
    q, k, v, g = jnp.split(proj, [R_QK_WIDTH, 2 * R_QK_WIDTH, 2 * R_QK_WIDTH + R_V_WIDTH], axis=-1)
    q = apply_rope(q.reshape(B, S, R_HEADS, R_QK_DIM), cos, sin)
    k = apply_rope(k.reshape(B, S, R_HEADS, R_QK_DIM), cos, sin) * (R_QK_DIM ** -0.5)
    v = v.reshape(B, S, R_HEADS, R_V_DIM)
    log_g = jnp.log1p(-jnp.exp2(-decay_exp.astype(jnp.float32)))
    fwd = chunk_retention(q, k, v, log_g[0], strict=False)
    bwd = jnp.flip(chunk_retention(jnp.flip(q, 1), jnp.flip(k, 1), jnp.flip(v, 1), log_g[1], strict=True), 1)
    o = head_group_norm(fwd + bwd).reshape(B, S, R_V_WIDTH)
    return (o * jax.nn.silu(g)) @ w_out


def setup_inputs(seed: int = 0) -> dict:
    key = jax.random.key(seed)
    ks = jax.random.split(key, 12)
    f32 = jnp.float32
    x = jax.random.normal(ks[0], (BATCH, SEQ, D_MODEL), f32)

    a_col_scale = jnp.concatenate([jnp.ones((A_WIDTH + A_KV_WIDTH,), f32),
                                   jnp.full((A_KV_WIDTH,), BETA, f32),
                                   jnp.ones((A_WIDTH,), f32)])
    attn_w_in = jax.random.normal(ks[1], (N_A_LAYERS, D_MODEL, A_IN), f32) * (D_MODEL ** -0.5) * a_col_scale
    attn_q_gain = 1.0 + 0.02 * jax.random.normal(ks[2], (N_A_LAYERS, A_HEAD_DIM), f32)
    attn_k_gain = 1.0 + 0.02 * jax.random.normal(ks[3], (N_A_LAYERS, A_HEAD_DIM), f32)
    attn_w_out = jax.random.normal(ks[4], (N_A_LAYERS, A_WIDTH, D_MODEL), f32) * (A_WIDTH ** -0.5) * BETA

    r_col_scale = jnp.concatenate([jnp.ones((2 * R_QK_WIDTH,), f32),
                                   jnp.full((R_V_WIDTH,), BETA, f32),
                                   jnp.ones((R_V_WIDTH,), f32)])
    ret_w_in = jax.random.normal(ks[5], (N_R_LAYERS, D_MODEL, R_IN), f32) * (D_MODEL ** -0.5) * r_col_scale
    base = R_DECAY_BASE + jnp.arange(R_HEADS, dtype=f32)
    base2 = jnp.stack([base, base[::-1]], axis=0)
    ret_decay_exp = base2[None] + 0.1 * jax.random.normal(ks[6], (N_R_LAYERS, 2, R_HEADS), f32)
    ret_w_out = jax.random.normal(ks[7], (N_R_LAYERS, R_V_WIDTH, D_MODEL), f32) * (R_V_WIDTH ** -0.5) * BETA

    ln_gain = 1.0 + 0.02 * jax.random.normal(ks[8], (DEPTH, D_MODEL), f32)
    ln_bias = 0.02 * jax.random.normal(ks[9], (DEPTH, D_MODEL), f32)
    return {"x": x, "attn_w_in": attn_w_in, "attn_q_gain": attn_q_gain, "attn_k_gain": attn_k_gain,
            "attn_w_out": attn_w_out, "ret_w_in": ret_w_in, "ret_decay_exp": ret_decay_exp,
            "ret_w_out": ret_w_out, "ln_gain": ln_gain, "ln_bias": ln_bias}


def reference(x, attn_w_in, attn_q_gain, attn_k_gain, attn_w_out, ret_w_in, ret_decay_exp,
              ret_w_out, ln_gain, ln_bias):
    S = x.shape[1]
    cos_a, sin_a = axial_rope_tables(S, A_HEAD_DIM)
    cos_r, sin_r = axial_rope_tables(S, R_QK_DIM)
    for i in range(DEPTH):
        j = i // N_MIXERS
        if i % N_MIXERS == 0:
            y = attention_mixer(x, attn_w_in[j], attn_q_gain[j], attn_k_gain[j], attn_w_out[j], cos_a, sin_a)
        else:
            y = retention_mixer(x, ret_w_in[j], ret_decay_exp[j], ret_w_out[j], cos_r, sin_r)
        x = layer_norm(ALPHA * x + y, ln_gain[i], ln_bias[i])
    return x
```

```cpp
#include <hip/hip_runtime.h>
#include <hip/hip_cooperative_groups.h>
#include <cstdio>
#include <cstdint>
namespace cg = cooperative_groups;

#define LAS __attribute__((address_space(3)))
typedef unsigned short bf16_t;
typedef short bf16x8 __attribute__((ext_vector_type(8)));
typedef short s16x4 __attribute__((ext_vector_type(4)));
typedef float f32x4 __attribute__((ext_vector_type(4)));
typedef float f32x2 __attribute__((ext_vector_type(2)));
typedef float f32x8 __attribute__((ext_vector_type(8)));
typedef float f32x16 __attribute__((ext_vector_type(16)));
typedef unsigned u32x4 __attribute__((ext_vector_type(4)));
typedef unsigned u32x2 __attribute__((ext_vector_type(2)));

constexpr int M_TOK = 16384, DM = 2048, SEQ = 4096;
constexpr int A_IN = 5120, R_IN = 12288;
constexpr float ALPHA = 1.681792830507429f;
constexpr float LN_EPS = 1e-5f, RMS_EPS = 1e-6f;

constexpr size_t MiB = 1u << 20;
constexpr size_t WS_TAB = 0;
constexpr size_t WS_WIN = 2 * MiB;
constexpr size_t WS_WOUT = 50 * MiB;
constexpr size_t WS_XCH = 82 * MiB;
constexpr size_t WS_PROJ = 84 * MiB;
constexpr size_t WS_OF = 468 * MiB;
constexpr size_t WS_XB = WS_OF;
constexpr size_t WS_OB = 596 * MiB;
constexpr size_t WS_END = 724 * MiB;
constexpr int LDS_BYTES = 143360;
constexpr int LDS_LN = 132096;

__device__ __forceinline__ unsigned f2bf(float f) { unsigned u = __builtin_bit_cast(unsigned, f); return (u + 0x7fffu + ((u >> 16) & 1u)) >> 16; }
__device__ __forceinline__ unsigned pk2(float lo, float hi) { return f2bf(lo) | (f2bf(hi) << 16); }
__device__ __forceinline__ float bf2f(unsigned short b) { return __builtin_bit_cast(float, (unsigned)b << 16); }
__device__ __forceinline__ float bflo(unsigned w) { return __builtin_bit_cast(float, w << 16); }
__device__ __forceinline__ float bfhi(unsigned w) { return __builtin_bit_cast(float, w & 0xffff0000u); }
__device__ __forceinline__ float wave_sum(float v) {
#pragma unroll
    for (int o = 1; o < 64; o <<= 1) v += __shfl_xor(v, o);
    return v;
}
__device__ __forceinline__ int opaque_tid() { int t = threadIdx.x; asm volatile("" : "+v"(t)); return t; }
__device__ __forceinline__ float silu_f(float g) { return g / (1.f + __expf(-g)); }

namespace pg8 {
constexpr int BM = 256, BK = 64, HALF = 128, HTB = HALF * BK * 2, STAGE_BYTES = 8 * HTB, NXCD = 8, WGM = 4;
__host__ __device__ __forceinline__ int lds_byte(int r, int c) { const int st = (r >> 4) * 2 + (c >> 5), rr = r & 15, cc = c & 31, ob = rr * 64 + cc * 2; return st * 1024 + (ob ^ (((ob >> 9) & 1) << 5)); }
__host__ __device__ __forceinline__ void stage_rc(int b, int& R, int& C) { const int st = b / 1024, sb = b % 1024, swz = sb ^ (((sb >> 9) & 1) << 5); R = (st >> 1) * 16 + swz / 64; C = (st & 1) * 32 + (swz % 64) / 2; }
__host__ __device__ __forceinline__ int perm32(int rho) { const int n = rho >> 4, i = rho & 15; return 8 * (i >> 2) + 4 * n + (i & 3); }

struct Unit { int pm, pn; };
struct Gemm { const bf16_t* A; const bf16_t* Bt; int M, N; };

struct StaticOrder {
    int nM, nN, nwg, G, c;
    __device__ void init(int M, int N, int G_, int c_) { nM = M / BM; nN = N / BM; nwg = nM * nN; G = G_; c = c_; }
    __device__ bool next(int i, Unit& u) const {
        const long L = (long)i * G + c; if (L >= nwg) return false;
        int wgid = (int)L; { const int q = nwg / NXCD, r = nwg % NXCD, xcd = wgid % NXCD, off = wgid / NXCD; wgid = (xcd < r ? xcd * (q + 1) : r * (q + 1) + (xcd - r) * q) + off; }
        const int nig = WGM * nN, gid = wgid / nig, fm = gid * WGM, gsz = (nM - fm) < WGM ? (nM - fm) : WGM;
        u.pm = fm + ((wgid % nig) % gsz); u.pn = (wgid % nig) / gsz; return true;
    }
};

__device__ __forceinline__ unsigned cvt_pk_bf16(float lo, float hi) { unsigned r; asm volatile("v_cvt_pk_bf16_f32 %0, %1, %2" : "=v"(r) : "v"(lo), "v"(hi)); return r; }

struct EpiBf16 {
    static constexpr bool PERM = true;
    bf16_t* O; int ldc; int rope_tiles; const float* cosT; const float* sinT;
    __device__ __forceinline__ void init(f32x4 (&acc)[2][2][4][2], const Unit&, int, int, int, int) const {
#pragma unroll
        for (int a = 0; a < 2; ++a)
#pragma unroll
            for (int b = 0; b < 2; ++b)
#pragma unroll
                for (int m = 0; m < 4; ++m)
#pragma unroll
                    for (int n = 0; n < 2; ++n) acc[a][b][m][n] = (f32x4){0.f, 0.f, 0.f, 0.f};
    }
    __device__ __forceinline__ void operator()(f32x4 (&acc)[2][2][4][2], const Unit& u, int wr, int wc, int fr, int fq, LAS unsigned char*) const {
        const int row0 = u.pm * BM + wr * 64 + fr;
        if (u.pn < rope_tiles) {
            const float sc = u.pn >= 8 ? 0.0625f : 1.f;
            const int i0 = (wc & 1) * 32 + fq * 8; const int colb = u.pn * BM + (wc >> 1) * 128 + (wc & 1) * 32 + fq * 8;
#pragma unroll
            for (int ai = 0; ai < 2; ++ai)
#pragma unroll
                for (int m = 0; m < 4; ++m) { const int row = row0 + ai * HALF + m * 16; const int t = row & (SEQ - 1); const int pos = (wc >> 1) ? (t & 63) : (t >> 6);
                    const f32x4 c0 = *(const f32x4*)(cosT + pos * 64 + i0), c1 = *(const f32x4*)(cosT + pos * 64 + i0 + 4), s0 = *(const f32x4*)(sinT + pos * 64 + i0), s1 = *(const f32x4*)(sinT + pos * 64 + i0 + 4);
                    const f32x4 x0 = acc[ai][0][m][0], x1 = acc[ai][0][m][1], y0 = acc[ai][1][m][0], y1 = acc[ai][1][m][1];
                    const f32x4 xa0 = (x0 * c0 - y0 * s0) * sc, xa1 = (x1 * c1 - y1 * s1) * sc, yb0 = (y0 * c0 + x0 * s0) * sc, yb1 = (y1 * c1 + x1 * s1) * sc;
                    bf16_t* rowp = O + (size_t)row * ldc + colb;
                    u32x4 w; w.x = cvt_pk_bf16(xa0[0], xa0[1]); w.y = cvt_pk_bf16(xa0[2], xa0[3]); w.z = cvt_pk_bf16(xa1[0], xa1[1]); w.w = cvt_pk_bf16(xa1[2], xa1[3]);
                    *(u32x4*)(rowp) = w;
                    w.x = cvt_pk_bf16(yb0[0], yb0[1]); w.y = cvt_pk_bf16(yb0[2], yb0[3]); w.z = cvt_pk_bf16(yb1[0], yb1[1]); w.w = cvt_pk_bf16(yb1[2], yb1[3]);
                    *(u32x4*)(rowp + 64) = w;
                    if (m & 1) asm volatile("" ::: "memory"); }
            return;
        }
        const int col0 = u.pn * BM + wc * 32 + 8 * fq;
#pragma unroll
        for (int ai = 0; ai < 2; ++ai)
#pragma unroll
            for (int m = 0; m < 4; ++m) { bf16_t* rowp = O + (size_t)(row0 + ai * HALF + m * 16) * ldc + col0;
#pragma unroll
                for (int bj = 0; bj < 2; ++bj) { const f32x4 v0 = acc[ai][bj][m][0], v1 = acc[ai][bj][m][1];
                    u32x4 w; w.x = cvt_pk_bf16(v0[0], v0[1]); w.y = cvt_pk_bf16(v0[2], v0[3]); w.z = cvt_pk_bf16(v1[0], v1[1]); w.w = cvt_pk_bf16(v1[2], v1[3]);
                    *(u32x4*)(rowp + bj * HALF) = w; } }
    }
};
struct PanelOrder {
    int c;
    __device__ bool next(int i, Unit& u) const { if (i >= 2) return false; const int x = c & 7, q = c >> 3; u.pm = 32 * i + 4 * x + (q >> 3); u.pn = q & 7; return true; }
};
struct EpiLN {
    static constexpr bool PERM = false;
    const float* xin; float* out; bf16_t* xb; const float* gain; const float* bias; f32x2* xch; unsigned* cnt; float alpha; int write_xb;
    __device__ __forceinline__ void init(f32x4 (&acc)[2][2][4][2], const Unit& u, int wr, int wc, int fr, int fq) const {
        const int col0 = u.pn * BM + wc * 32 + 4 * fq;
#pragma unroll
        for (int ai = 0; ai < 2; ++ai)
#pragma unroll
            for (int m = 0; m < 4; ++m) { const size_t off = (size_t)(u.pm * BM + ai * HALF + wr * 64 + m * 16 + fr) * DM + col0;
#pragma unroll
                for (int bj = 0; bj < 2; ++bj)
#pragma unroll
                    for (int n = 0; n < 2; ++n) acc[ai][bj][m][n] = *(const f32x4*)(xin + off + bj * HALF + n * 16) * alpha; }
    }
    __device__ __forceinline__ void operator()(f32x4 (&acc)[2][2][4][2], const Unit& u, int wr, int wc, int fr, int fq, LAS unsigned char* lds) const {
        LAS f32x2* P = (LAS f32x2*)(lds + LDS_LN); LAS f32x2* ST = (LAS f32x2*)(lds + LDS_LN + 8192); LAS unsigned* flagw = (LAS unsigned*)(lds + LDS_LN + 8192 + 2048);
        const int tid = opaque_tid(), lane = tid & 63, wid = __builtin_amdgcn_readfirstlane(tid >> 6);
        const int col0 = u.pn * BM + wc * 32 + 4 * fq;
#pragma unroll
        for (int ai = 0; ai < 2; ++ai)
#pragma unroll
            for (int m = 0; m < 4; ++m) { float sv = 0.f, qv = 0.f;
#pragma unroll
                for (int bj = 0; bj < 2; ++bj)
#pragma unroll
                    for (int n = 0; n < 2; ++n) { const f32x4 x = acc[ai][bj][m][n]; sv += (x[0] + x[1]) + (x[2] + x[3]); qv += (x[0] * x[0] + x[1] * x[1]) + (x[2] * x[2] + x[3] * x[3]); }
                sv += __shfl_xor(sv, 16); sv += __shfl_xor(sv, 32); qv += __shfl_xor(qv, 16); qv += __shfl_xor(qv, 32);
                if (fq == 0) P[(ai * HALF + wr * 64 + m * 16 + fr) * 4 + wc] = (f32x2){sv, qv};
                __builtin_amdgcn_sched_barrier(0); }
        asm volatile("s_waitcnt lgkmcnt(0)" ::: "memory"); __builtin_amdgcn_s_barrier(); asm volatile("" ::: "memory");
        unsigned* pc = cnt + 16 * u.pm;
        if (tid < 256) { const f32x2 a = P[tid * 4 + 0], b = P[tid * 4 + 1], c = P[tid * 4 + 2], d = P[tid * 4 + 3];
            const float sv = (a.x + b.x) + (c.x + d.x), qv = (a.y + b.y) + (c.y + d.y);
            unsigned long long* slot = (unsigned long long*)xch + ((size_t)(u.pm * BM + tid) * 8 + u.pn);
            __hip_atomic_store(slot, ((unsigned long long)__float_as_uint(qv) << 32) | __float_as_uint(sv), __ATOMIC_RELAXED, __HIP_MEMORY_SCOPE_AGENT);
            asm volatile("s_waitcnt vmcnt(0)" ::: "memory");
            if (lane == 0) __hip_atomic_fetch_add(pc, 1u, __ATOMIC_RELAXED, __HIP_MEMORY_SCOPE_AGENT); }
        if (wid == 0) { unsigned sp = 0;
            while ((unsigned)__builtin_amdgcn_readfirstlane(__hip_atomic_load(pc, __ATOMIC_RELAXED, __HIP_MEMORY_SCOPE_AGENT)) < 32u) { __builtin_amdgcn_s_sleep(2); if (++sp > (1u << 20)) break; }
            __builtin_amdgcn_fence(__ATOMIC_ACQUIRE, "agent"); if (lane == 0) flagw[0] = sp; }
        asm volatile("s_waitcnt vmcnt(0) lgkmcnt(0)" ::: "memory"); __builtin_amdgcn_s_barrier(); asm volatile("" ::: "memory");
        if (tid < 256) { const unsigned long long* slot = (const unsigned long long*)xch + (size_t)(u.pm * BM + tid) * 8; float sv = 0.f, qv = 0.f;
#pragma unroll
            for (int t = 0; t < 8; ++t) { const unsigned long long w = __hip_atomic_load(slot + t, __ATOMIC_RELAXED, __HIP_MEMORY_SCOPE_AGENT); sv += __uint_as_float((unsigned)w); qv += __uint_as_float((unsigned)(w >> 32)); }
            const float mean = sv * (1.f / DM); const float var = fmaxf(qv * (1.f / DM) - mean * mean, 0.f);
            ST[tid] = (f32x2){mean, 1.f / sqrtf(var + LN_EPS)}; }
        asm volatile("s_waitcnt lgkmcnt(0)" ::: "memory"); __builtin_amdgcn_s_barrier(); asm volatile("" ::: "memory");
#pragma unroll
        for (int ai = 0; ai < 2; ++ai)
#pragma unroll
            for (int m = 0; m < 4; ++m) { const int r = ai * HALF + wr * 64 + m * 16 + fr; const f32x2 sr = ST[r]; const size_t off = (size_t)(u.pm * BM + r) * DM + col0;
#pragma unroll
                for (int bj = 0; bj < 2; ++bj)
#pragma unroll
                    for (int n = 0; n < 2; ++n) { const f32x4 gn = *(const f32x4*)(gain + col0 + bj * HALF + n * 16), bs = *(const f32x4*)(bias + col0 + bj * HALF + n * 16);
                        const f32x4 o = (acc[ai][bj][m][n] - sr.x) * sr.y * gn + bs; *(f32x4*)(out + off + bj * HALF + n * 16) = o;
                        if (write_xb) { u32x2 w; w.x = cvt_pk_bf16(o[0], o[1]); w.y = cvt_pk_bf16(o[2], o[3]); *(u32x2*)(xb + off + bj * HALF + n * 16) = w; }
                        __builtin_amdgcn_sched_barrier(0); }
                asm volatile("" ::: "memory"); }
    }
};

template <class Epi, int K, int lda, class Sched = StaticOrder, bool ALIGN_EPI = true>
__device__ __forceinline__ void gemm_phase(LAS unsigned char* lds, const Gemm g, const Sched& S, const Epi& E) {
    const int tid = opaque_tid(), wid = __builtin_amdgcn_readfirstlane(tid >> 6), lane = tid & 63, wr = wid >> 2, wc = wid & 3, fr = lane & 15, fq = lane >> 4;
    constexpr int nt = K / BK;
    unsigned voffA[2], voffB[2];
#pragma unroll
    for (int i = 0; i < 2; ++i) { int R, C; stage_rc(tid * 16 + i * 8192, R, C); const int Rb = Epi::PERM ? ((R & ~31) + perm32(R & 31)) : R;
        voffA[i] = (unsigned)(R * lda + C) * 2u; voffB[i] = (unsigned)(Rb * K + C) * 2u; }
    constexpr size_t kstep = (size_t)(BK * 2);
    constexpr size_t hstepA = (size_t)HALF * lda * 2, hstepB = (size_t)HALF * K * 2;
    constexpr size_t tstepA = 2 * hstepA, tstepB = 2 * hstepB;
    const unsigned ldsw = (unsigned)wid * 1024u;
    const int aoff = lds_byte(wr * 64 + fr, fq * 8), boff = lds_byte(wc * 32 + fr, fq * 8);
#define PG8_SA(b, h) (((b) * 2 + (h)) * HTB)
#define PG8_SB(b, h) ((4 + (b) * 2 + (h)) * HTB)
#define PG8_STAGE(bufoff, gbase, voff) do { _Pragma("unroll") for (int _i = 0; _i < 2; ++_i) \
        __builtin_amdgcn_global_load_lds((const unsigned*)((const char*)(gbase) + (voff)[_i]), (LAS unsigned*)(lds + (bufoff) + ldsw + _i * 8192), 16, 0, 0); } while (0)
#define PG8_LDA(dst, b, h) do { _Pragma("unroll") for (int m = 0; m < 4; ++m) _Pragma("unroll") for (int k = 0; k < 2; ++k) dst[m][k] = *(const LAS bf16x8*)(lds + PG8_SA(b, h) + aoff + m * 2048 + k * 1024); } while (0)
#define PG8_LDB(dst, b, h) do { _Pragma("unroll") for (int n = 0; n < 2; ++n) _Pragma("unroll") for (int k = 0; k < 2; ++k) dst[n][k] = *(const LAS bf16x8*)(lds + PG8_SB(b, h) + boff + n * 2048 + k * 1024); } while (0)
#define PG8_MMA(ai, bj, At, Bt) do { __builtin_amdgcn_s_setprio(1); _Pragma("unroll") for (int m = 0; m < 4; ++m) _Pragma("unroll") for (int n = 0; n < 2; ++n) _Pragma("unroll") for (int k = 0; k < 2; ++k) \
        acc[ai][bj][m][n] = __builtin_amdgcn_mfma_f32_16x16x32_bf16(Bt[n][k], At[m][k], acc[ai][bj][m][n], 0, 0, 0); __builtin_amdgcn_s_setprio(0); } while (0)
#define PG8_WAIT_V(n) asm volatile("s_waitcnt vmcnt(" #n ")" ::: "memory")
#define PG8_WAIT_L(n) asm volatile("s_waitcnt lgkmcnt(" #n ")" ::: "memory")
#define PG8_BAR __builtin_amdgcn_s_barrier()
#define PG8_SCHED __builtin_amdgcn_sched_barrier(0)
    Unit cur, nxt; int ui = 0;
    if (!S.next(0, cur)) return;
    f32x4 acc[2][2][4][2];
    E.init(acc, cur, wr, wc, fr, fq);
    bf16x8 At[4][2], B0[2][2], B1[2][2];
    const char* cA = (const char*)g.A + (size_t)cur.pm * tstepA; const char* cB = (const char*)g.Bt + (size_t)cur.pn * tstepB;
    PG8_STAGE(PG8_SB(0, 0), cB, voffB); PG8_STAGE(PG8_SB(0, 1), cB + hstepB, voffB); PG8_STAGE(PG8_SA(0, 0), cA, voffA); PG8_STAGE(PG8_SA(0, 1), cA + hstepA, voffA);
    if (wr == 1) PG8_BAR;
    PG8_WAIT_V(2); PG8_BAR;
    PG8_STAGE(PG8_SB(1, 0), cB + kstep, voffB); PG8_STAGE(PG8_SA(1, 0), cA + kstep, voffA); PG8_STAGE(PG8_SB(1, 1), cB + hstepB + kstep, voffB);
    PG8_WAIT_V(6); PG8_BAR;
    for (;;) {
        const bool has_next = S.next(ui + 1, nxt);
        const char* nA = has_next ? (const char*)g.A + (size_t)nxt.pm * tstepA : cA; const char* nB = has_next ? (const char*)g.Bt + (size_t)nxt.pn * tstepB : cB;
        for (int t = 0; t < nt; t += 2) {
            const bool last = (t == nt - 2);
            const char* a1 = cA + (size_t)(t + 1) * kstep;
            const char* a2 = last ? nA : cA + (size_t)(t + 2) * kstep; const char* b2 = last ? nB : cB + (size_t)(t + 2) * kstep;
            const char* a3 = a2 + kstep; const char* b3 = b2 + kstep;
            PG8_LDB(B0, 0, 0); PG8_LDB(B1, 0, 1); PG8_SCHED; PG8_LDA(At, 0, 0); PG8_STAGE(PG8_SA(1, 1), a1 + hstepA, voffA);
            PG8_WAIT_V(8); PG8_WAIT_L(0); PG8_BAR; PG8_MMA(0, 0, At, B0); PG8_MMA(0, 1, At, B1); PG8_BAR; PG8_SCHED;
            PG8_LDA(At, 0, 1); PG8_STAGE(PG8_SB(0, 0), b2, voffB); PG8_STAGE(PG8_SB(0, 1), b2 + hstepB, voffB); PG8_STAGE(PG8_SA(0, 0), a2, voffA);
            PG8_WAIT_V(8); PG8_WAIT_L(0); PG8_BAR; PG8_MMA(1, 0, At, B0); PG8_MMA(1, 1, At, B1); PG8_BAR; PG8_SCHED;
            PG8_LDB(B0, 1, 0); PG8_LDB(B1, 1, 1); PG8_SCHED; PG8_LDA(At, 1, 0); PG8_STAGE(PG8_SA(0, 1), a2 + hstepA, voffA);
            PG8_WAIT_V(8); PG8_WAIT_L(0); PG8_BAR; PG8_MMA(0, 0, At, B0); PG8_MMA(0, 1, At, B1); PG8_BAR; PG8_SCHED;
            PG8_LDA(At, 1, 1); PG8_STAGE(PG8_SB(1, 0), b3, voffB); PG8_STAGE(PG8_SB(1, 1), b3 + hstepB, voffB); PG8_STAGE(PG8_SA(1, 0), a3, voffA);
            PG8_WAIT_V(8); PG8_WAIT_L(0); PG8_BAR; PG8_MMA(1, 0, At, B0); PG8_MMA(1, 1, At, B1); PG8_BAR; PG8_SCHED;
        }
        if constexpr (ALIGN_EPI) { if (wr == 0) PG8_BAR; }
        E(acc, cur, wr, wc, fr, fq, lds);
        if (!has_next) break;
        cur = nxt; cA = nA; cB = nB; ++ui;
        E.init(acc, cur, wr, wc, fr, fq);
        if constexpr (ALIGN_EPI) { if (wr == 1) PG8_BAR; }
    }
    PG8_WAIT_V(0);
    if constexpr (!ALIGN_EPI) { if (wr == 0) PG8_BAR; }
    PG8_BAR;
#undef PG8_SA
#undef PG8_SB
#undef PG8_STAGE
#undef PG8_LDA
#undef PG8_LDB
#undef PG8_MMA
#undef PG8_WAIT_V
#undef PG8_WAIT_L
#undef PG8_BAR
#undef PG8_SCHED
}
}

namespace att {
constexpr int D = 128, NW = 8, QBLK = 32, KVBLK = 64;
constexpr float SCALE = 0.088388347648318440f;
constexpr float THR = 8.f;
constexpr int LDQ = A_IN, LDK = A_IN, LDO = DM;
constexpr int SHM_V = KVBLK * D * 2, SHM_K = KVBLK * D * 2;
#define KSWZ(row, colB) ((row) * 256 + ((colB) ^ (((row) & 7) << 4)))
#define SBAR() __builtin_amdgcn_sched_barrier(0)
__device__ __forceinline__ int crow(int r, int hi) { return (r & 3) + 8 * (r >> 2) + 4 * hi; }
__device__ __forceinline__ unsigned cvtpk(float lo, float hi) { unsigned r; asm volatile("v_cvt_pk_bf16_f32 %0, %1, %2" : "=v"(r) : "v"(lo), "v"(hi)); return r; }
__device__ __forceinline__ bf16x8 ld8(const bf16_t* p) { return *reinterpret_cast<const bf16x8*>(p); }

__device__ __forceinline__ void partialSM(f32x16& p0, f32x16& p1, float& m_reg, float& mn, float& alpha) {
  constexpr float C = SCALE * 1.4426950408889634f;
  float pmax = p0[0]; for (int r = 1; r < 16; ++r) pmax = fmaxf(pmax, p0[r]); for (int r = 0; r < 16; ++r) pmax = fmaxf(pmax, p1[r]);
  { auto rr = __builtin_amdgcn_permlane32_swap(__float_as_uint(pmax), __float_as_uint(pmax), false, false);
    pmax = fmaxf(__uint_as_float(rr[0]), __uint_as_float(rr[1])); }
  if (__builtin_expect(__all(pmax - m_reg <= THR / SCALE), 1)) { mn = m_reg; alpha = 1.f; }
  else { mn = fmaxf(m_reg, pmax); alpha = __builtin_amdgcn_exp2f((m_reg - mn) * C); m_reg = mn; }
  float mnC = -mn * C;
  for (int r = 0; r < 16; ++r) p0[r] = fmaf(p0[r], C, mnC); for (int r = 0; r < 16; ++r) p1[r] = fmaf(p1[r], C, mnC);
  for (int r = 0; r < 16; ++r) p0[r] = __builtin_amdgcn_exp2f(p0[r]);
}
__device__ __forceinline__ void finishSM(f32x16& p0, f32x16& p1, float alpha, float& l_reg, bf16x8& pa0, bf16x8& pa1, bf16x8& pa2, bf16x8& pa3) {
  for (int r = 0; r < 16; ++r) p1[r] = __builtin_amdgcn_exp2f(p1[r]);
  float ps = 0; for (int r = 0; r < 16; ++r) ps += p0[r]; for (int r = 0; r < 16; ++r) ps += p1[r];
  { auto rr = __builtin_amdgcn_permlane32_swap(__float_as_uint(ps), __float_as_uint(ps), false, false);
    ps = __uint_as_float(rr[0]) + __uint_as_float(rr[1]); }
  l_reg = l_reg * alpha + ps;
#define PK4(P, BASE, OUT) do { unsigned a0 = cvtpk(P[BASE + 0], P[BASE + 1]), a1 = cvtpk(P[BASE + 2], P[BASE + 3]);   \
    unsigned b0 = cvtpk(P[BASE + 4], P[BASE + 5]), b1 = cvtpk(P[BASE + 6], P[BASE + 7]);                              \
    auto r0 = __builtin_amdgcn_permlane32_swap(a0, b0, false, false); auto r1 = __builtin_amdgcn_permlane32_swap(a1, b1, false, false); \
    u32x4 w = {r0[0], r1[0], r0[1], r1[1]}; OUT = *reinterpret_cast<bf16x8*>(&w); } while (0)
  PK4(p0, 0, pa0); PK4(p0, 8, pa1); PK4(p1, 0, pa2); PK4(p1, 8, pa3);
#undef PK4
}
__device__ __forceinline__ void qkt(f32x16& p0, f32x16& p1, const char* Ks, const bf16x8* qr, int r32, int hi) {
  p0 = f32x16{}; p1 = f32x16{};
  for (int d0 = 0; d0 < 8; ++d0) { int cb = (d0 * 16 + hi * 8) * 2;
    bf16x8 b0 = *reinterpret_cast<const bf16x8*>(Ks + KSWZ(r32, cb));
    bf16x8 b1 = *reinterpret_cast<const bf16x8*>(Ks + KSWZ(32 + r32, cb));
    __builtin_amdgcn_s_setprio(1);
    p0 = __builtin_amdgcn_mfma_f32_32x32x16_bf16(b0, qr[d0], p0, 0, 0, 0);
    p1 = __builtin_amdgcn_mfma_f32_32x32x16_bf16(b1, qr[d0], p1, 0, 0, 0);
    __builtin_amdgcn_s_setprio(0); }
}
__device__ __forceinline__ int v_st(int k, int c) { const int kk = (k & ~0xC) | ((k & 4) << 1) | ((k & 8) >> 1); return ((kk >> 3) * 4 + (c >> 5)) * 512 + ((kk & 7) * 32 + (c & 31)) * 2; }
__device__ __forceinline__ int v_rd_base(int lane) { return ((lane & 3) << 3) | (((lane >> 2) & 3) << 6) | (((lane >> 4) & 1) << 5) | (((lane >> 5) & 1) << 8); }
constexpr int v_rd_off(int d0, int ks, int half) { return d0 * 512 + ks * 4096 + half * 2048; }
template <int OFF> __device__ __forceinline__ s16x4 tr_read(int vb) {
  s16x4 r; asm volatile("ds_read_b64_tr_b16 %0, %1 offset:%2" : "=&v"(r) : "v"(vb), "i"(OFF) : "memory"); return r;
}
template <int D0> __device__ __forceinline__ void pv_one(f32x16& od, int vb, bf16x8 pa0, bf16x8 pa1, bf16x8 pa2, bf16x8 pa3) {
  const s16x4 l0 = tr_read<v_rd_off(D0, 0, 0)>(vb), h0 = tr_read<v_rd_off(D0, 0, 1)>(vb), l1 = tr_read<v_rd_off(D0, 1, 0)>(vb), h1 = tr_read<v_rd_off(D0, 1, 1)>(vb);
  const s16x4 l2 = tr_read<v_rd_off(D0, 2, 0)>(vb), h2 = tr_read<v_rd_off(D0, 2, 1)>(vb), l3 = tr_read<v_rd_off(D0, 3, 0)>(vb), h3 = tr_read<v_rd_off(D0, 3, 1)>(vb);
  asm volatile("s_waitcnt lgkmcnt(0)" ::: "memory"); SBAR();
#define PK(L, H) (bf16x8){L[0], L[1], L[2], L[3], H[0], H[1], H[2], H[3]}
  __builtin_amdgcn_s_setprio(1);
  od = __builtin_amdgcn_mfma_f32_32x32x16_bf16(pa0, PK(l0, h0), od, 0, 0, 0);
  od = __builtin_amdgcn_mfma_f32_32x32x16_bf16(pa1, PK(l1, h1), od, 0, 0, 0);
  od = __builtin_amdgcn_mfma_f32_32x32x16_bf16(pa2, PK(l2, h2), od, 0, 0, 0);
  od = __builtin_amdgcn_mfma_f32_32x32x16_bf16(pa3, PK(l3, h3), od, 0, 0, 0);
  __builtin_amdgcn_s_setprio(0);
#undef PK
}
__device__ __forceinline__ void pv_d0(f32x16* o, int vb, bf16x8 pa0, bf16x8 pa1, bf16x8 pa2, bf16x8 pa3) {
  pv_one<0>(o[0], vb, pa0, pa1, pa2, pa3); pv_one<1>(o[1], vb, pa0, pa1, pa2, pa3); pv_one<2>(o[2], vb, pa0, pa1, pa2, pa3); pv_one<3>(o[3], vb, pa0, pa1, pa2, pa3);
}
__device__ __forceinline__ void attn_body(const bf16_t* Qb, const bf16_t* Kh, const bf16_t* Vh, const bf16_t* Gb, bf16_t* Ob, int seq, char* lds,
                                          const float* qgain, const float* cosA, const float* sinA, int t0) {
  const int tid = opaque_tid(), wid = tid >> 6, lane = tid & 63, r32 = lane & 31, hi = lane >> 5;
  char* V_lds = lds; char* K_lds = lds + 2 * SHM_V;
  float* ws = (float*)(lds + 2 * SHM_V + 2 * SHM_K) + wid * 64; float* li_l = ws; float* al_l = ws + 32;
  float m_reg = -1e30f, l_reg = 0; f32x16 o[4] = {}; bf16x8 qr[8];
  const bf16_t* Qw = Qb + (long)(wid * QBLK + r32) * LDQ + hi * 8;
#pragma unroll
  for (int d0 = 0; d0 < 8; ++d0) qr[d0] = ld8(Qw + d0 * 16);
  {
    float ss = 0.f;
#pragma unroll
    for (int d0 = 0; d0 < 8; ++d0)
#pragma unroll
      for (int e = 0; e < 8; ++e) { const float v = bf2f((unsigned short)qr[d0][e]); ss += v * v; }
    { auto rr = __builtin_amdgcn_permlane32_swap(__float_as_uint(ss), __float_as_uint(ss), false, false); ss = __uint_as_float(rr[0]) + __uint_as_float(rr[1]); }
    const float rinv = 1.f / sqrtf(ss * (1.f / 128) + RMS_EPS);
    const int t = t0 + wid * QBLK + r32, rp = t >> 6, cp = t & 63;
#pragma unroll
    for (int half = 0; half < 2; ++half) { const int pos = half ? cp : rp;
#pragma unroll
      for (int dd = 0; dd < 2; ++dd) { const int dx = 4 * half + dd, dy = dx + 2, i0 = 16 * dd + 8 * hi;
        const f32x4 c0 = *(const f32x4*)(cosA + pos * 32 + i0), c1 = *(const f32x4*)(cosA + pos * 32 + i0 + 4), s0 = *(const f32x4*)(sinA + pos * 32 + i0), s1 = *(const f32x4*)(sinA + pos * 32 + i0 + 4);
        const f32x4 gx0 = *(const f32x4*)(qgain + 16 * dx + 8 * hi), gx1 = *(const f32x4*)(qgain + 16 * dx + 8 * hi + 4), gy0 = *(const f32x4*)(qgain + 16 * dy + 8 * hi), gy1 = *(const f32x4*)(qgain + 16 * dy + 8 * hi + 4);
        float xo[8], yo[8];
#pragma unroll
        for (int e = 0; e < 8; ++e) { const float cc = e < 4 ? c0[e & 3] : c1[e & 3], sn = e < 4 ? s0[e & 3] : s1[e & 3];
          const float x = bf2f((unsigned short)qr[dx][e]) * rinv * (e < 4 ? gx0[e & 3] : gx1[e & 3]), y = bf2f((unsigned short)qr[dy][e]) * rinv * (e < 4 ? gy0[e & 3] : gy1[e & 3]);
          xo[e] = x * cc - y * sn; yo[e] = y * cc + x * sn; }
        u32x4 wx = {cvtpk(xo[0], xo[1]), cvtpk(xo[2], xo[3]), cvtpk(xo[4], xo[5]), cvtpk(xo[6], xo[7])}, wy = {cvtpk(yo[0], yo[1]), cvtpk(yo[2], yo[3]), cvtpk(yo[4], yo[5]), cvtpk(yo[6], yo[7])};
        qr[dx] = *reinterpret_cast<bf16x8*>(&wx); qr[dy] = *reinterpret_cast<bf16x8*>(&wy); } }
  }
  const int sr = tid >> 4, sc = (tid & 15) * 8, vst0 = v_st(sr, sc), vst1 = v_st(32 + sr, sc);
  const int vb0 = (int)(uintptr_t)V_lds + v_rd_base(lane);
  struct { bf16x8 vs0, vs1, ks0, ks1; } sr_[2];
#define SLOAD(i, k0) do { sr_[i].vs0 = ld8(&Vh[(long)((k0) + sr) * LDK + sc]); sr_[i].vs1 = ld8(&Vh[(long)((k0) + 32 + sr) * LDK + sc]); \
    sr_[i].ks0 = ld8(&Kh[(long)((k0) + sr) * LDK + sc]); sr_[i].ks1 = ld8(&Kh[(long)((k0) + 32 + sr) * LDK + sc]); } while (0)
#define SWRITE(b, i) do { *(bf16x8*)(V_lds + (b) * SHM_V + vst0) = sr_[i].vs0;          \
    *(bf16x8*)(V_lds + (b) * SHM_V + vst1) = sr_[i].vs1; int kc = sc * 2;               \
    *(bf16x8*)(K_lds + (b) * SHM_K + KSWZ(sr, kc)) = sr_[i].ks0;                       \
    *(bf16x8*)(K_lds + (b) * SHM_K + KSWZ(32 + sr, kc)) = sr_[i].ks1; } while (0)
#define SWAIT() asm volatile("s_waitcnt vmcnt(4)" ::: "memory")
#define RESC(a) do { if (__any((a) < 1.f)) { if (hi == 0) al_l[r32] = (a); asm volatile("s_waitcnt lgkmcnt(0)" ::: "memory"); \
    for (int d = 0; d < 4; ++d) for (int r = 0; r < 16; ++r) o[d][r] *= al_l[crow(r, hi)]; } } while (0)
  f32x16 pA0, pA1, pB0, pB1; float mnA, mnB, alA, alB; bf16x8 pa0, pa1, pa2, pa3; const int NT = seq / KVBLK;
  constexpr int SE = 0, SO = 1;
  SLOAD(SE, 0); asm volatile("s_waitcnt vmcnt(0)" ::: "memory"); SWRITE(0, SE); __syncthreads();
  qkt(pA0, pA1, K_lds, qr, r32, hi); partialSM(pA0, pA1, m_reg, mnA, alA);
  SLOAD(SO, KVBLK); if (2 < NT) SLOAD(SE, 2 * KVBLK);
  SWAIT(); SWRITE(1, SO); __syncthreads();
  for (int j = 1; j + 1 < NT; j += 2) {
    SBAR(); qkt(pB0, pB1, K_lds + SHM_K, qr, r32, hi);
    finishSM(pA0, pA1, alA, l_reg, pa0, pa1, pa2, pa3); SBAR();
    SLOAD(SO, (j + 2) * KVBLK); SBAR();
    pv_d0(o, vb0, pa0, pa1, pa2, pa3); partialSM(pB0, pB1, m_reg, mnB, alB);
    __syncthreads(); SWAIT(); SWRITE(0, SE);
    RESC(alB); __syncthreads();
    SBAR(); qkt(pA0, pA1, K_lds, qr, r32, hi);
    finishSM(pB0, pB1, alB, l_reg, pa0, pa1, pa2, pa3); SBAR();
    if (j + 3 < NT) SLOAD(SE, (j + 3) * KVBLK); SBAR();
    pv_d0(o, vb0 + (int)SHM_V, pa0, pa1, pa2, pa3); partialSM(pA0, pA1, m_reg, mnA, alA);
    __syncthreads(); SWAIT(); SWRITE(1, SO);
    RESC(alA); __syncthreads();
  }
  SBAR(); qkt(pB0, pB1, K_lds + SHM_K, qr, r32, hi);
  finishSM(pA0, pA1, alA, l_reg, pa0, pa1, pa2, pa3); SBAR();
  pv_d0(o, vb0, pa0, pa1, pa2, pa3); partialSM(pB0, pB1, m_reg, mnB, alB);
  __syncthreads(); RESC(alB);
  finishSM(pB0, pB1, alB, l_reg, pa0, pa1, pa2, pa3); SBAR();
  pv_d0(o, vb0 + (int)SHM_V, pa0, pa1, pa2, pa3);
  if (hi == 0) li_l[r32] = l_reg; asm volatile("s_waitcnt lgkmcnt(0)" ::: "memory");
  float rli[16];
#pragma unroll
  for (int r = 0; r < 16; ++r) rli[r] = __builtin_amdgcn_rcpf(li_l[crow(r, hi)]);
  __syncthreads();
  char* ot = lds + wid * 8704;
#pragma unroll
  for (int r = 0; r < 16; ++r) { const int orow = crow(r, hi);
#pragma unroll
    for (int d0 = 0; d0 < 4; ++d0) *(bf16_t*)(ot + orow * 272 + (d0 * 32 + r32) * 2) = (bf16_t)f2bf(o[d0][r] * rli[r]); }
  asm volatile("s_waitcnt lgkmcnt(0)" ::: "memory");
  bf16_t* Ow = Ob + (long)(wid * QBLK) * LDO; const bf16_t* Gw = Gb + (long)(wid * QBLK) * LDQ;
  u32x4 gq[8];
#pragma unroll
  for (int k = 0; k < 8; ++k) { const int pc = lane & 15, row = (lane >> 4) + 4 * k; gq[k] = *(const u32x4*)(Gw + (long)row * LDQ + pc * 8); }
#pragma unroll
  for (int k = 0; k < 8; ++k) { const int pc = lane & 15, row = (lane >> 4) + 4 * k; const u32x4 ov = *(const u32x4*)(ot + row * 272 + pc * 16); u32x4 w;
#pragma unroll
    for (int e = 0; e < 4; ++e) w[e] = cvtpk(bflo(ov[e]) * silu_f(bflo(gq[k][e])), bfhi(ov[e]) * silu_f(bfhi(gq[k][e])));
    *(u32x4*)(Ow + (long)row * LDO + pc * 8) = w; }
#undef SLOAD
#undef SWRITE
#undef SWAIT
#undef RESC
}
#undef KSWZ
#undef SBAR
}

namespace ret {
constexpr int CH = 64;
constexpr int RSQ = 576, RSV = 272, RSS = 144;
constexpr int QS = 0, KS = 36864, VS = 73728, SP = 91136, END = 100352;
__device__ __forceinline__ s16x4 trd(LAS unsigned char* p) { return __builtin_bit_cast(s16x4, __builtin_amdgcn_ds_read_tr16_b64_v4i16((LAS s16x4*)p)); }
__device__ __forceinline__ bf16x8 cat(s16x4 a, s16x4 b) { return (bf16x8){a[0], a[1], a[2], a[3], b[0], b[1], b[2], b[3]}; }
#define MF16(a, b, c) __builtin_amdgcn_mfma_f32_16x16x32_bf16((a), (b), (c), 0, 0, 0)
#define RBAR() do { asm volatile("s_waitcnt lgkmcnt(0)" ::: "memory"); __builtin_amdgcn_s_barrier(); asm volatile("" ::: "memory"); } while (0)
__device__ __forceinline__ unsigned cvtpk(float lo, float hi) { unsigned r; asm volatile("v_cvt_pk_bf16_f32 %0, %1, %2" : "=v"(r) : "v"(lo), "v"(hi)); return r; }
#define SCHED() __builtin_amdgcn_sched_barrier(0)
__device__ __forceinline__ void ret_item(LAS unsigned char* lds, const bf16_t* proj, bf16_t* OD, int b, int h, int dir, int vs, float lg2) {
    const int tid = opaque_tid(), wid = __builtin_amdgcn_readfirstlane(tid >> 6), lane = tid & 63, l15 = lane & 15, g = lane >> 4, q4 = l15 >> 2, pp = l15 & 3;
    const bf16_t* Qg = proj + (size_t)(b * SEQ) * R_IN + h * 256;
    const bf16_t* Kg = Qg + 2048;
    const bf16_t* Vg = proj + (size_t)(b * SEQ) * R_IN + 4096 + h * 512 + vs * 128;
    bf16_t* Og = OD + (size_t)(b * SEQ) * 4096 + h * 512 + vs * 128 + 16 * wid + 4 * g;
    f32x4 st[16];
#pragma unroll
    for (int i = 0; i < 16; ++i) st[i] = (f32x4){0.f, 0.f, 0.f, 0.f};
    const int qrow = tid >> 5, qpc = tid & 31, vrow = tid >> 4, vpc = tid & 15;
    bf16x8 pq[4], pk[4], pv[2];
    const float c16 = __builtin_amdgcn_exp2f(16.f * lg2), c32 = c16 * c16, c48 = c32 * c16, cd = c32 * c32;
    const float qdl = __builtin_amdgcn_exp2f((float)(dir ? 16 - l15 : l15 + 1) * lg2);
    float kd8[8], d4[4];
#pragma unroll
    for (int r = 0; r < 4; ++r) d4[r] = __builtin_amdgcn_exp2f((float)(dir ? 4 * g + r - l15 : l15 - 4 * g - r) * lg2);
#pragma unroll
    for (int jj = 0; jj < 8; ++jj) kd8[jj] = __builtin_amdgcn_exp2f((float)(dir ? 8 * g + jj : 31 - 8 * g - jj) * lg2);
    const int b3 = (l15 >> 3) & 1, sit = wid >> 1, sjt0 = 2 * (wid & 1), lo2 = 32 * (g & 1) + 8 * (g >> 1);
    LAS unsigned char* pSk = lds + KS + (16 * sjt0 + l15) * RSQ + ((16 * g) ^ (32 * b3));
    LAS unsigned char* pSq = lds + QS + (16 * sit + l15) * RSQ + (lo2 ^ (32 * b3));
    LAS unsigned char* pCq = lds + QS + l15 * RSQ + ((16 * g) ^ (32 * b3));
    LAS unsigned char* pIs = lds + SP + l15 * RSS + 16 * g;
    LAS unsigned char* pVt = lds + VS + (8 * g + q4) * RSV + (16 * wid + 4 * pp) * 2;
    LAS unsigned char* pKe = lds + KS + (8 * g + q4) * RSQ + 8 * pp + 32 * (g & 1);
    LAS unsigned char* pKo = lds + KS + (8 * g + q4) * RSQ + 8 * pp - 32 * (g & 1);
    const int sb3 = (qrow >> 3) & 1;
    LAS unsigned char* wQ = lds + QS + qrow * RSQ + ((16 * qpc) ^ (32 * sb3));
    LAS unsigned char* wK0 = lds + KS + qrow * RSQ + ((64 * (qpc >> 2) + 8 * (qpc & 3)) ^ (32 * sb3));
    LAS unsigned char* wK1 = lds + KS + qrow * RSQ + ((64 * (qpc >> 2) + 32 + 8 * (qpc & 3)) ^ (32 * sb3));
    {   const int c0 = dir ? 63 : 0; const size_t t0 = (size_t)c0 * CH;
#pragma unroll
        for (int k = 0; k < 4; ++k) { pq[k] = *(const bf16x8*)(Qg + (t0 + qrow + 16 * k) * R_IN + qpc * 8); pk[k] = *(const bf16x8*)(Kg + (t0 + qrow + 16 * k) * R_IN + qpc * 8); }
#pragma unroll
        for (int k = 0; k < 2; ++k) pv[k] = *(const bf16x8*)(Vg + (t0 + vrow + 32 * k) * R_IN + vpc * 8);
    }
#pragma unroll 1
    for (int step = 0; step < 64; ++step) {
        const int c = dir ? 63 - step : step; const size_t t0 = (size_t)c * CH;
#pragma unroll
        for (int k = 0; k < 4; ++k) { *(LAS bf16x8*)(wQ + 16 * k * RSQ) = pq[k];
            *(LAS s16x4*)(wK0 + 16 * k * RSQ) = (s16x4){pk[k][0], pk[k][1], pk[k][2], pk[k][3]}; *(LAS s16x4*)(wK1 + 16 * k * RSQ) = (s16x4){pk[k][4], pk[k][5], pk[k][6], pk[k][7]}; }
#pragma unroll
        for (int k = 0; k < 2; ++k) *(LAS bf16x8*)(lds + VS + (vrow + 32 * k) * RSV + vpc * 16) = pv[k];
        if (step + 1 < 64) { const int c1 = dir ? 62 - step : step + 1; const size_t t1 = (size_t)c1 * CH;
#pragma unroll
            for (int k = 0; k < 4; ++k) { pq[k] = *(const bf16x8*)(Qg + (t1 + qrow + 16 * k) * R_IN + qpc * 8); pk[k] = *(const bf16x8*)(Kg + (t1 + qrow + 16 * k) * R_IN + qpc * 8); }
#pragma unroll
            for (int k = 0; k < 2; ++k) pv[k] = *(const bf16x8*)(Vg + (t1 + vrow + 32 * k) * R_IN + vpc * 8);
        }
        RBAR();
        {   f32x4 sa0 = (f32x4){0.f, 0.f, 0.f, 0.f}, sa1 = sa0;
            s16x4 fq[2][2]; bf16x8 fk0[2], fk1[2];
#define LDS_S(buf, s) do { fq[buf][0] = *(const LAS s16x4*)(pSq + 64 * (s)); fq[buf][1] = *(const LAS s16x4*)(pSq + 64 * (s) + 16); fk0[buf] = *(const LAS bf16x8*)(pSk + 64 * (s)); fk1[buf] = *(const LAS bf16x8*)(pSk + 16 * RSQ + 64 * (s)); } while (0)
            LDS_S(0, 0);
#pragma unroll
            for (int s = 0; s < 8; ++s) { if (s < 7) LDS_S((s + 1) & 1, s + 1); SCHED();
                const bf16x8 bq = cat(fq[s & 1][0], fq[s & 1][1]);
                __builtin_amdgcn_s_setprio(1); sa0 = MF16(fk0[s & 1], bq, sa0); sa1 = MF16(fk1[s & 1], bq, sa1); __builtin_amdgcn_s_setprio(0); SCHED(); }
#undef LDS_S
#pragma unroll
            for (int tt = 0; tt < 2; ++tt) { const f32x4 sv = tt ? sa1 : sa0; const int dt = dir ? (sjt0 + tt - sit) : (sit - sjt0 - tt);
                const float cs = dt <= 0 ? 1.f : dt == 1 ? c16 : dt == 2 ? c32 : c48; float w[4];
#pragma unroll
                for (int r = 0; r < 4; ++r) { const bool on = dt > 0 || (dt == 0 && (dir ? (4 * g + r > l15) : (l15 >= 4 * g + r))); w[r] = on ? sv[r] * d4[r] * cs : 0.f; }
                u32x2 pkd; pkd.x = cvtpk(w[0], w[1]); pkd.y = cvtpk(w[2], w[3]);
                *(LAS u32x2*)(lds + SP + (16 * sit + l15) * RSS + (16 * (sjt0 + tt) + 4 * g) * 2) = pkd; }
        }
        RBAR();
        f32x4 acc[4];
#pragma unroll
        for (int it = 0; it < 4; ++it) acc[it] = (f32x4){0.f, 0.f, 0.f, 0.f};
        {   bf16x8 ca[2][4];
#define LDS_C(buf, s) do { _Pragma("unroll") for (int it = 0; it < 4; ++it) ca[buf][it] = *(const LAS bf16x8*)(pCq + 16 * it * RSQ + 64 * (s)); } while (0)
            LDS_C(0, 0);
#pragma unroll
            for (int s = 0; s < 8; ++s) { if (s < 7) LDS_C((s + 1) & 1, s + 1); SCHED();
                u32x4 bw; bw.x = cvtpk(st[2 * s][0], st[2 * s][1]); bw.y = cvtpk(st[2 * s][2], st[2 * s][3]); bw.z = cvtpk(st[2 * s + 1][0], st[2 * s + 1][1]); bw.w = cvtpk(st[2 * s + 1][2], st[2 * s + 1][3]);
                const bf16x8 bs = __builtin_bit_cast(bf16x8, bw);
                __builtin_amdgcn_s_setprio(1);
#pragma unroll
                for (int it = 0; it < 4; ++it) acc[it] = MF16(bs, ca[s & 1][it], acc[it]);
                __builtin_amdgcn_s_setprio(0); SCHED(); }
#undef LDS_C
        }
        bf16x8 bv[2], ia[2][4];
#pragma unroll
        for (int s = 0; s < 2; ++s) { bv[s] = cat(trd(pVt + 32 * s * RSV), trd(pVt + (32 * s + 4) * RSV));
#pragma unroll
            for (int it = 0; it < 4; ++it) ia[s][it] = *(const LAS bf16x8*)(pIs + 16 * it * RSS + 64 * s); }
        s16x4 ua[2][4][2];
#define LDS_U(buf, u) do { _Pragma("unroll") for (int k = 0; k < 4; ++k) { LAS unsigned char* pb = ((k & 1) ? pKo : pKe) + 32 * ((u) >> 2) * RSQ + 32 * (4 * ((u) & 3) + k); ua[buf][k][0] = trd(pb); ua[buf][k][1] = trd(pb + 4 * RSQ); } } while (0)
        LDS_U(0, 0);
        SCHED();
#pragma unroll
        for (int it = 0; it < 4; ++it) { const int ex = dir ? 3 - it : it; const float cq = qdl * (ex == 0 ? 1.f : ex == 1 ? c16 : ex == 2 ? c32 : c48); acc[it] = acc[it] * cq; }
#pragma unroll
        for (int s = 0; s < 2; ++s)
#pragma unroll
            for (int it = 0; it < 4; ++it) acc[it] = MF16(bv[s], ia[s][it], acc[it]);
        SCHED();
#pragma unroll
        for (int i = 0; i < 16; ++i) st[i] = st[i] * cd;
        bf16x8 bvd[2];
#pragma unroll
        for (int s = 0; s < 2; ++s) { const float ck = (dir ? s : 1 - s) ? c32 : 1.f; float e[8];
#pragma unroll
            for (int jj = 0; jj < 8; ++jj) e[jj] = bf2f((unsigned short)bv[s][jj]) * (kd8[jj] * ck);
            u32x4 bw; bw.x = cvtpk(e[0], e[1]); bw.y = cvtpk(e[2], e[3]); bw.z = cvtpk(e[4], e[5]); bw.w = cvtpk(e[6], e[7]);
            bvd[s] = __builtin_bit_cast(bf16x8, bw); }
#pragma unroll
        for (int u = 0; u < 8; ++u) { if (u < 7) LDS_U((u + 1) & 1, u + 1); SCHED();
            __builtin_amdgcn_s_setprio(1);
#pragma unroll
            for (int k = 0; k < 4; ++k) st[4 * (u & 3) + k] = MF16(cat(ua[u & 1][k][0], ua[u & 1][k][1]), bvd[u >> 2], st[4 * (u & 3) + k]);
            __builtin_amdgcn_s_setprio(0); SCHED(); }
#undef LDS_U
#pragma unroll
        for (int it = 0; it < 4; ++it) { u32x2 w; w.x = cvtpk(acc[it][0], acc[it][1]); w.y = cvtpk(acc[it][2], acc[it][3]); *(u32x2*)(Og + (t0 + 16 * it + l15) * 4096) = w; }
        RBAR();
    }
    asm volatile("s_waitcnt vmcnt(0) lgkmcnt(0)" ::: "memory"); __builtin_amdgcn_s_barrier();
}
#undef SCHED
#undef MF16
#undef RBAR
}

struct Params {
    const float* x; const float* a_win; const float* a_qg; const float* a_kg; const float* a_wout;
    const float* r_win; const float* r_dec; const float* r_wout; const float* ln_g; const float* ln_b;
    float* out; unsigned char* ws;
};

__device__ __forceinline__ void sincos_acc(float ang, float& c, float& s) {
    const double x = (double)ang;
    const double k = __builtin_rint(x * 0.6366197723675814);
    double r = __builtin_fma(-k, 1.5707963267948966, x);
    r = __builtin_fma(-k, 6.123233995736766e-17, r);
    const double r2 = r * r;
    const double sp = r * (1.0 + r2 * (-1.0 / 6 + r2 * (1.0 / 120 + r2 * (-1.0 / 5040 + r2 * (1.0 / 362880 + r2 * (-1.0 / 39916800 + r2 * (1.0 / 6227020800.0)))))));
    const double cp = 1.0 + r2 * (-0.5 + r2 * (1.0 / 24 + r2 * (-1.0 / 720 + r2 * (1.0 / 40320 + r2 * (-1.0 / 3628800 + r2 * (1.0 / 479001600 + r2 * (-1.0 / 87178291200.0)))))));
    const int q = ((int)k) & 3;
    const double sv = (q == 0) ? sp : (q == 1) ? cp : (q == 2) ? -sp : -cp;
    const double cv = (q == 0) ? cp : (q == 1) ? -sp : (q == 2) ? -cp : sp;
    c = (float)cv; s = (float)sv;
}
__device__ __forceinline__ void build_tables(const Params& p) {
    float* tab = (float*)(p.ws + WS_TAB);
    const int gt = blockIdx.x * 512 + opaque_tid();
    if (gt < 2048) {
        const int pos = gt >> 5, i = gt & 31; double f = 1.0; for (int k = 0; k < i; ++k) f *= 0.7498942093324559;
        const float ang = (float)pos * (float)f; float c, s; sincos_acc(ang, c, s); tab[gt] = c; tab[2048 + gt] = s;
    } else if (gt < 2048 + 4096) {
        const int t = gt - 2048; const int pos = t >> 6, i = t & 63; double f = 1.0; for (int k = 0; k < i; ++k) f *= 0.8659643233600653;
        const float ang = (float)pos * (float)f; float c, s; sincos_acc(ang, c, s); tab[4096 + t] = c; tab[8192 + t] = s;
    }
}
__device__ __forceinline__ void transpose_item(const float* W, int K, int N, bf16_t* WT, LAS float* scr, int item, int lane, int perm_cols) {
    const int nblk = N / 32, kb = item / nblk, nb = item % nblk, k0 = 64 * kb, n0 = 32 * nb;
#pragma unroll 8
    for (int i = 0; i < 32; ++i) { const int kk = 2 * i + (lane >> 5); scr[kk * 33 + (lane & 31)] = W[(size_t)(k0 + kk) * N + n0 + (lane & 31)]; }
    asm volatile("s_waitcnt lgkmcnt(0)" ::: "memory");
    const int c = lane & 7;
#pragma unroll
    for (int j = 0; j < 4; ++j) { const int n = (lane >> 3) + 8 * j; const LAS float* s = scr + (8 * c) * 33 + n;
        u32x4 o; o.x = pk2(s[0 * 33], s[1 * 33]); o.y = pk2(s[2 * 33], s[3 * 33]); o.z = pk2(s[4 * 33], s[5 * 33]); o.w = pk2(s[6 * 33], s[7 * 33]);
        int rowi = n0 + n;
        if (rowi < perm_cols) { const int oc = rowi & 255, part = oc >> 6, i6 = oc & 63; rowi = (rowi & ~255) + 128 * (part & 1) + 32 * (2 * (part >> 1) + (i6 >> 5)) + (i6 & 31); }
        *(u32x4*)(WT + (size_t)rowi * K + k0 + 8 * c) = o; }
    asm volatile("s_waitcnt lgkmcnt(0)" ::: "memory");
}
__device__ __forceinline__ void convert_weights(const Params& p, int L, LAS unsigned char* lds) {
    const int tid = opaque_tid(), lane = tid & 63, wave = __builtin_amdgcn_readfirstlane(tid >> 6), gw = blockIdx.x * 8 + wave, NGW = gridDim.x * 8;
    LAS float* scr = (LAS float*)(lds + wave * 16384);
    const int j = L >> 1;
    bf16_t* WinT = (bf16_t*)(p.ws + WS_WIN); bf16_t* WoutT = (bf16_t*)(p.ws + WS_WOUT + (size_t)(L & 1) * 16 * MiB);
    if (!(L & 1)) {
        const float* Win = p.a_win + (size_t)j * DM * A_IN; const float* Wout = p.a_wout + (size_t)j * DM * DM;
        constexpr int I_in = (DM / 64) * (A_IN / 32), I_out = (DM / 64) * (DM / 32);
        for (int it = gw; it < I_in + I_out; it += NGW) {
            if (it < I_in) transpose_item(Win, DM, A_IN, WinT, scr, it, lane, 0);
            else transpose_item(Wout, DM, DM, WoutT, scr, it - I_in, lane, 0);
        }
    } else {
        const float* Win = p.r_win + (size_t)j * DM * R_IN; const float* Wout = p.r_wout + (size_t)j * 4096 * DM;
        constexpr int I_in = (DM / 64) * (R_IN / 32), I_out = (4096 / 64) * (DM / 32);
        for (int it = gw; it < I_in + I_out; it += NGW) {
            if (it < I_in) transpose_item(Win, DM, R_IN, WinT, scr, it, lane, 4096);
            else transpose_item(Wout, 4096, DM, WoutT, scr, it - I_in, lane, 0);
        }
    }
}
__device__ __forceinline__ void ln_rows(const float* src, float* dst, bf16_t* xb, const float* gain, const float* bias, bool do_ln, bool write_xb) {
    const int tid = opaque_tid(), lane = tid & 63, wave = __builtin_amdgcn_readfirstlane(tid >> 6), gw = blockIdx.x * 8 + wave, NGW = gridDim.x * 8;
    for (int m0 = gw * 2; m0 < M_TOK; m0 += NGW * 2) {
        f32x4 v[2][8];
#pragma unroll
        for (int r = 0; r < 2; ++r) { const f32x4* xr = (const f32x4*)(src + (size_t)(m0 + r) * DM) + lane;
#pragma unroll
            for (int j = 0; j < 8; ++j) v[r][j] = xr[64 * j]; }
#pragma unroll
        for (int r = 0; r < 2; ++r) { const int m = m0 + r;
            if (do_ln) {
                float s = 0.f;
#pragma unroll
                for (int j = 0; j < 8; ++j) s += (v[r][j].x + v[r][j].y) + (v[r][j].z + v[r][j].w);
                const float mean = wave_sum(s) * (1.f / DM); float s2 = 0.f;
#pragma unroll
                for (int j = 0; j < 8; ++j) { v[r][j] = v[r][j] - mean; s2 += (v[r][j].x * v[r][j].x + v[r][j].y * v[r][j].y) + (v[r][j].z * v[r][j].z + v[r][j].w * v[r][j].w); }
                const float rstd = 1.f / sqrtf(wave_sum(s2) * (1.f / DM) + LN_EPS);
#pragma unroll
                for (int j = 0; j < 8; ++j) { const f32x4 gn = ((const f32x4*)gain)[64 * j + lane], bs = ((const f32x4*)bias)[64 * j + lane]; v[r][j] = v[r][j] * rstd * gn + bs; }
                f32x4* orow = (f32x4*)(dst + (size_t)m * DM) + lane;
#pragma unroll
                for (int j = 0; j < 8; ++j) orow[64 * j] = v[r][j];
            }
            if (write_xb) {
                u32x2* o8 = (u32x2*)(xb + (size_t)m * DM) + lane;
#pragma unroll
                for (int j = 0; j < 8; ++j) { u32x2 w; w.x = pk2(v[r][j].x, v[r][j].y); w.y = pk2(v[r][j].z, v[r][j].w); o8[64 * j] = w; }
            }
        }
    }
}
__device__ __forceinline__ void prep_attn(const Params& p, int j) {
    const int tid = opaque_tid(), lane = tid & 63, wave = __builtin_amdgcn_readfirstlane(tid >> 6), gw = blockIdx.x * 8 + wave, NGW = gridDim.x * 8;
    bf16_t* proj = (bf16_t*)(p.ws + WS_PROJ); const float* tab = (const float*)(p.ws + WS_TAB);
    const float* cosA = tab; const float* sinA = tab + 2048;
    const int sub = lane & 15, part = sub >> 2, i0 = 8 * (sub & 3);
    const f32x4 g0 = *(const f32x4*)(p.a_kg + j * 128 + 8 * sub), g1 = *(const f32x4*)(p.a_kg + j * 128 + 8 * sub + 4);
    for (int m0 = gw * 4; m0 < M_TOK; m0 += NGW * 4) {
        u32x4 w[4];
#pragma unroll
        for (int r = 0; r < 4; ++r) w[r] = *((const u32x4*)(proj + (size_t)(m0 + r) * A_IN + 2048) + lane);
#pragma unroll
        for (int r = 0; r < 4; ++r) { const int m = m0 + r, t = m & (SEQ - 1), pos = part < 2 ? (t >> 6) : (t & 63);
            float x[8];
#pragma unroll
            for (int e = 0; e < 4; ++e) { x[2 * e] = bflo(w[r][e]); x[2 * e + 1] = bfhi(w[r][e]); }
            float ss = 0.f;
#pragma unroll
            for (int e = 0; e < 8; ++e) ss += x[e] * x[e];
            ss += __shfl_xor(ss, 1); ss += __shfl_xor(ss, 2); ss += __shfl_xor(ss, 4); ss += __shfl_xor(ss, 8);
            const float rinv = 1.f / sqrtf(ss * (1.f / 128) + RMS_EPS);
#pragma unroll
            for (int e = 0; e < 8; ++e) x[e] *= rinv * (e < 4 ? g0[e & 3] : g1[e & 3]);
            const f32x4 c0 = *(const f32x4*)(cosA + pos * 32 + i0), c1 = *(const f32x4*)(cosA + pos * 32 + i0 + 4), s0 = *(const f32x4*)(sinA + pos * 32 + i0), s1 = *(const f32x4*)(sinA + pos * 32 + i0 + 4);
            float o[8];
#pragma unroll
            for (int e = 0; e < 8; ++e) { const float y = __shfl_xor(x[e], 4); const float cc = e < 4 ? c0[e & 3] : c1[e & 3], sn = e < 4 ? s0[e & 3] : s1[e & 3];
                o[e] = (part & 1) ? x[e] * cc + y * sn : x[e] * cc - y * sn; }
            u32x4 wo; wo.x = pk2(o[0], o[1]); wo.y = pk2(o[2], o[3]); wo.z = pk2(o[4], o[5]); wo.w = pk2(o[6], o[7]);
            *((u32x4*)(proj + (size_t)m * A_IN + 2048) + lane) = wo; }
    }
}
__device__ __forceinline__ void gn_gate(const Params& p) {
    const int tid = opaque_tid(), lane = tid & 63, wave = __builtin_amdgcn_readfirstlane(tid >> 6), gw = blockIdx.x * 8 + wave, NGW = gridDim.x * 8;
    bf16_t* proj = (bf16_t*)(p.ws + WS_PROJ); const bf16_t* OF = (const bf16_t*)(p.ws + WS_OF); const bf16_t* OBp = (const bf16_t*)(p.ws + WS_OB);
    for (int it = gw; it < M_TOK * 2; it += NGW) {
        const int m = it >> 1, h0 = 4 * (it & 1);
        u32x4 wf[4], wb[4], wg[4];
#pragma unroll
        for (int k = 0; k < 4; ++k) { wf[k] = *((const u32x4*)(OF + (size_t)m * 4096 + (h0 + k) * 512) + lane); wb[k] = *((const u32x4*)(OBp + (size_t)m * 4096 + (h0 + k) * 512) + lane);
            wg[k] = *((const u32x4*)(proj + (size_t)m * R_IN + 8192 + (h0 + k) * 512) + lane); }
#pragma unroll
        for (int k = 0; k < 4; ++k) {
            float o[8], gv[8];
#pragma unroll
            for (int e = 0; e < 4; ++e) { o[2 * e] = bflo(wf[k][e]) + bflo(wb[k][e]); o[2 * e + 1] = bfhi(wf[k][e]) + bfhi(wb[k][e]); gv[2 * e] = bflo(wg[k][e]); gv[2 * e + 1] = bfhi(wg[k][e]); }
            float s = 0.f;
#pragma unroll
            for (int e = 0; e < 8; ++e) s += o[e];
            const float mean = wave_sum(s) * (1.f / 512); float s2 = 0.f;
#pragma unroll
            for (int e = 0; e < 8; ++e) { o[e] -= mean; s2 += o[e] * o[e]; }
            const float rstd = 1.f / sqrtf(wave_sum(s2) * (1.f / 512) + LN_EPS);
            u32x4 w;
#pragma unroll
            for (int e = 0; e < 4; ++e) w[e] = pk2(o[2 * e] * rstd * silu_f(gv[2 * e]), o[2 * e + 1] * rstd * silu_f(gv[2 * e + 1]));
            *((u32x4*)(proj + (size_t)m * R_IN + 8192 + (h0 + k) * 512) + lane) = w;
        }
    }
}

constexpr size_t WS_BAR = 1536 * 1024;
constexpr size_t WS_PCNT = WS_BAR + 16384;
#define XB_TMO      128
#define XB_XCNT(j)  (256  + 64 * (j))
#define XB_XSUB(j)  (1280 + 64 * (j))
#define XB_XGEN(j)  (2304 + 64 * (j))
#define XB_TOP      3328
#define XB_TOPGEN   3392
#define XCD_BAR_WORDS 3456
#define XB_SPIN_CAP (1u << 18)
__device__ __forceinline__ unsigned xb_ld(unsigned* p)              { return __hip_atomic_load(p, __ATOMIC_RELAXED, __HIP_MEMORY_SCOPE_AGENT); }
__device__ __forceinline__ unsigned xb_add(unsigned* p, unsigned v) { return __hip_atomic_fetch_add(p, v, __ATOMIC_RELAXED, __HIP_MEMORY_SCOPE_AGENT); }
__device__ __forceinline__ unsigned xb_xcc_id() { return (unsigned)__builtin_amdgcn_s_getreg((3 << 11) | 20) & 0xFu; }
#define XB_SPIN(cond, bar) do { unsigned _sp = 0; while (cond) { __builtin_amdgcn_s_sleep(1); \
    if ((++_sp & 255u) == 0u) { if (xb_ld(&(bar)[XB_TMO])) break; if (_sp > XB_SPIN_CAP) { atomicAdd(&(bar)[XB_TMO], 1u); break; } } } } while (0)
struct XcdBarrier { unsigned* bar; unsigned x; volatile LAS unsigned* st; };
__device__ __forceinline__ XcdBarrier xcd_barrier_post(unsigned* bar, volatile LAS unsigned* st) {
    XcdBarrier b; b.bar = bar; b.x = xb_xcc_id(); b.st = st;
    if (threadIdx.x == 0) (void)xb_add(&bar[XB_XCNT(b.x)], 1u);
    return b;
}
__device__ __forceinline__ void xcd_barrier_complete(unsigned* bar, unsigned x, unsigned& nloc, unsigned& nx) {
    const unsigned G = gridDim.x * gridDim.y * gridDim.z;
    unsigned sum, cnt, mine, sp = 0u;
    for (;;) {
        sum = 0u; cnt = 0u; mine = 0u;
#pragma unroll
        for (unsigned j = 0; j < 16; ++j) { const unsigned c = xb_ld(&bar[XB_XCNT(j)]); sum += c; cnt += (c > 0u) ? 1u : 0u; mine = (j == x) ? c : mine; }
        if (sum == G) break;
        __builtin_amdgcn_s_sleep(1);
        if ((++sp & 255u) == 0u) { if (xb_ld(&bar[XB_TMO])) break; if (sp > XB_SPIN_CAP) { atomicAdd(&bar[XB_TMO], 1u); break; } }
    }
    nloc = mine > 0u ? mine : 1u; nx = cnt > 0u ? cnt : 1u;
}
__device__ __forceinline__ void xcd_barrier(const XcdBarrier& b) {
    asm volatile("s_waitcnt vmcnt(0)" ::: "memory");
    __syncthreads();
    if (threadIdx.x == 0) {
        unsigned* bar = b.bar;
        __builtin_amdgcn_s_waitcnt(0);
        unsigned nloc = b.st[0], nx = b.st[1];
        if (nloc == 0u) { xcd_barrier_complete(bar, b.x, nloc, nx); b.st[0] = nloc; b.st[1] = nx; }
        const unsigned old = xb_add(&bar[XB_XSUB(b.x)], 1u);
        const unsigned gen = old / nloc;
        if (old + 1u == (gen + 1u) * nloc) {
            __builtin_amdgcn_fence(__ATOMIC_RELEASE, "agent");
            asm volatile("s_waitcnt vmcnt(0)" ::: "memory");
            const unsigned og = xb_add(&bar[XB_TOP], 1u);
            const unsigned tg = og / nx;
            if (og + 1u == (tg + 1u) * nx) xb_add(&bar[XB_TOPGEN], 1u);
            else XB_SPIN(xb_ld(&bar[XB_TOPGEN]) == tg, bar);
            __builtin_amdgcn_fence(__ATOMIC_ACQUIRE, "agent");
            xb_add(&bar[XB_XGEN(b.x)], 1u);
            asm volatile("s_waitcnt vmcnt(0)" ::: "memory");
        } else {
            XB_SPIN(xb_ld(&bar[XB_XGEN(b.x)]) == gen, bar);
            __builtin_amdgcn_fence(__ATOMIC_ACQUIRE, "agent");
            asm volatile("s_waitcnt vmcnt(0)" ::: "memory");
        }
    }
    __syncthreads();
}

__global__ void __launch_bounds__(512, 2) mega_fwd(Params p) {
    extern __shared__ __attribute__((aligned(16))) unsigned char lds_raw[];
    LAS unsigned char* lds = (LAS unsigned char*)lds_raw;
    cg::grid_group grid = cg::this_grid();
    const int G = gridDim.x, bx = blockIdx.x;
    bf16_t* proj = (bf16_t*)(p.ws + WS_PROJ); bf16_t* xb = (bf16_t*)(p.ws + WS_XB);
    bf16_t* WinT = (bf16_t*)(p.ws + WS_WIN); bf16_t* WoutT = (bf16_t*)(p.ws + WS_WOUT);
    bf16_t* OF = (bf16_t*)(p.ws + WS_OF); bf16_t* OB = (bf16_t*)(p.ws + WS_OB);

    {   unsigned* barw = (unsigned*)(p.ws + WS_BAR); const int t0 = opaque_tid();
        if (bx == 0) for (int i = t0; i < 4096 + 4096; i += 512) barw[i] = 0u;
        if (t0 < 2) ((volatile LAS unsigned*)(lds + 131072))[t0] = 0u; }
    build_tables(p);
    convert_weights(p, 0, lds);
    ln_rows(p.x, nullptr, xb, nullptr, nullptr, false, true);
    grid.sync();
    const XcdBarrier xbar = xcd_barrier_post((unsigned*)(p.ws + WS_BAR), (volatile LAS unsigned*)(lds + 131072));
#define GSYNC() xcd_barrier(xbar)

#pragma unroll 1
    for (int L = 0; L < 4; ++L) {
        const int j = L >> 1; const bool isA = !(L & 1);
        bf16_t* WoutL = (bf16_t*)(p.ws + WS_WOUT + (size_t)(L & 1) * 16 * MiB);
        {   pg8::Gemm g{xb, WinT, M_TOK, isA ? A_IN : R_IN}; pg8::StaticOrder S; S.init(M_TOK, g.N, G, bx);
            pg8::EpiBf16 E{proj, g.N, isA ? 0 : 16, (const float*)(p.ws + WS_TAB) + 4096, (const float*)(p.ws + WS_TAB) + 8192};
            pg8::gemm_phase<pg8::EpiBf16, DM, DM>(lds, g, S, E);
        }
        GSYNC();
        if (isA) {
            prep_attn(p, j);
            GSYNC();
            for (int u = bx; u < 1024; u += G) {
                const int b = u >> 8, w = u & 255, xcd = w & 7, slot = w >> 3, h = 2 * xcd + (slot >> 4), qb = slot & 15, kvh = h >> 2;
                const bf16_t* rowb = proj + (size_t)(b * SEQ) * A_IN;
                att::attn_body(rowb + (size_t)(qb * 256) * A_IN + h * 128, rowb + 2048 + kvh * 128, rowb + 2560 + kvh * 128,
                               rowb + (size_t)(qb * 256) * A_IN + 3072 + h * 128, OB + (size_t)(b * SEQ + qb * 256) * DM + h * 128, SEQ, (char*)lds_raw,
                               p.a_qg + j * 128, (const float*)(p.ws + WS_TAB), (const float*)(p.ws + WS_TAB) + 2048, qb * 256);
                __syncthreads();
            }
        } else {
            for (int u = bx; u < 256; u += G) {
                const int xcd = u & 7, slot = u >> 3, bh = xcd * 4 + (slot >> 3), sub = slot & 7, dir = sub >> 2, vs = sub & 3, b = bh >> 3, h = bh & 7;
                const float e = p.r_dec[j * 16 + dir * 8 + h]; const float xg = __builtin_amdgcn_exp2f(-e);
                const float lg = -(xg * (1.f + xg * (0.5f + xg * (1.f / 3 + xg * (0.25f + xg * (0.2f + xg * (1.f / 6)))))));
                ret::ret_item(lds, proj, dir ? OB : OF, b, h, dir, vs, lg * 1.4426950408889634f);
            }
            GSYNC();
            gn_gate(p);
        }
        GSYNC();
        const bool late_group = ((bx >> 6) & 1) != 0;
        if (L < 3 && late_group) { convert_weights(p, L + 1, lds); __syncthreads(); }
        {   pg8::EpiLN E{L == 0 ? p.x : p.out, p.out, xb, p.ln_g + L * DM, p.ln_b + L * DM, (f32x2*)(p.ws + WS_XCH), (unsigned*)(p.ws + WS_PCNT) + L * 1024, ALPHA, L < 3 ? 1 : 0};
            pg8::PanelOrder PO{bx};
            if (isA) { pg8::Gemm g{OB, WoutL, M_TOK, DM}; pg8::gemm_phase<pg8::EpiLN, DM, DM, pg8::PanelOrder>(lds, g, PO, E); }
            else { pg8::Gemm g{proj + 8192, WoutL, M_TOK, DM}; pg8::gemm_phase<pg8::EpiLN, 4096, R_IN, pg8::PanelOrder>(lds, g, PO, E); }
        }
        if (L < 3 && !late_group) convert_weights(p, L + 1, lds);
        if (L < 3) GSYNC();
    }
}

extern "C" void kernel_launch(void* const* d_in, const int* in_sizes, int n_in, void* d_out, int out_size, void* d_ws, size_t ws_size, hipStream_t stream) {
    static int grid_blocks = 0;
    if (grid_blocks == 0) {
        if (n_in != 10 || out_size != M_TOK * DM || ws_size < WS_END) { fprintf(stderr, "kernel_launch: unexpected shapes / workspace (n_in %d out %d ws %zu, need %zu)\n", n_in, out_size, ws_size, (size_t)WS_END); grid_blocks = -1; return; }
        int dev = 0, cus = 0, per_cu = 0;
        hipGetDevice(&dev);
        hipDeviceGetAttribute(&cus, hipDeviceAttributeMultiprocessorCount, dev);
        hipFuncSetAttribute((const void*)mega_fwd, hipFuncAttributeMaxDynamicSharedMemorySize, LDS_BYTES);
        hipOccupancyMaxActiveBlocksPerMultiprocessor(&per_cu, (const void*)mega_fwd, 512, LDS_BYTES);
        if (per_cu < 1) per_cu = 1;
        grid_blocks = cus * per_cu;
        if (grid_blocks > 256) grid_blocks = 256;
        if (grid_blocks != 256) { fprintf(stderr, "kernel_launch: this kernel needs a 256-workgroup grid (got %d)\n", grid_blocks); grid_blocks = -1; return; }
        (void)hipGetLastError();
    }
    if (grid_blocks < 0) return;
    Params p{};
    p.x = (const float*)d_in[0]; p.a_win = (const float*)d_in[1]; p.a_qg = (const float*)d_in[2]; p.a_kg = (const float*)d_in[3]; p.a_wout = (const float*)d_in[4];
    p.r_win = (const float*)d_in[5]; p.r_dec = (const float*)d_in[6]; p.r_wout = (const float*)d_in[7]; p.ln_g = (const float*)d_in[8]; p.ln_b = (const float*)d_in[9];
    p.out = (float*)d_out; p.ws = (unsigned char*)d_ws;
    void* args[] = {&p};
    hipError_t e = hipLaunchCooperativeKernel((const void*)mega_fwd, dim3(grid_blocks), dim3(512), args, LDS_BYTES, stream);
    if (e != hipSuccess) fprintf(stderr, "cooperative launch failed: %s (grid %d)\n", hipGetErrorString(e), grid_blocks);
}
```

```cpp
#include <hip/hip_runtime.h>
#include <hip/hip_cooperative_groups.h>
#include <cstdio>
#include <cstdint>
namespace cg = cooperative_groups;

#define LAS __attribute__((address_space(3)))
typedef unsigned short bf16_t;
typedef short bf16x8 __attribute__((ext_vector_type(8)));
typedef short s16x4 __attribute__((ext_vector_type(4)));
typedef float f32x4 __attribute__((ext_vector_type(4)));
typedef float f32x2 __attribute__((ext_vector_type(2)));
typedef float f32x8 __attribute__((ext_vector_type(8)));
typedef float f32x16 __attribute__((ext_vector_type(16)));
typedef unsigned u32x4 __attribute__((ext_vector_type(4)));
typedef unsigned u32x2 __attribute__((ext_vector_type(2)));

constexpr int M_TOK = 16384, DM = 2048, SEQ = 4096;
constexpr int A_IN = 5120, R_IN = 12288;
constexpr float ALPHA = 1.681792830507429f;
constexpr float LN_EPS = 1e-5f, RMS_EPS = 1e-6f;

constexpr size_t MiB = 1u << 20;
constexpr size_t WS_TAB = 0;
constexpr size_t WS_WIN = 2 * MiB;
constexpr size_t WS_WOUT = 50 * MiB;
constexpr size_t WS_XCH = 82 * MiB;
constexpr size_t WS_PROJ = 84 * MiB;
constexpr size_t WS_OF = 468 * MiB;
constexpr size_t WS_XB = WS_OF;
constexpr size_t WS_OB = 596 * MiB;
constexpr size_t WS_END = 724 * MiB;
constexpr int LDS_BYTES = 143360;
constexpr int LDS_LN = 132096;

__device__ __forceinline__ unsigned f2bf(float f) { unsigned u = __builtin_bit_cast(unsigned, f); return (u + 0x7fffu + ((u >> 16) & 1u)) >> 16; }
__device__ __forceinline__ unsigned pk2(float lo, float hi) { return f2bf(lo) | (f2bf(hi) << 16); }
__device__ __forceinline__ float bf2f(unsigned short b) { return __builtin_bit_cast(float, (unsigned)b << 16); }
__device__ __forceinline__ float bflo(unsigned w) { return __builtin_bit_cast(float, w << 16); }
__device__ __forceinline__ float bfhi(unsigned w) { return __builtin_bit_cast(float, w & 0xffff0000u); }
__device__ __forceinline__ float wave_sum(float v) {
#pragma unroll
    for (int o = 1; o < 64; o <<= 1) v += __shfl_xor(v, o);
    return v;
}
__device__ __forceinline__ int opaque_tid() { int t = threadIdx.x; asm volatile("" : "+v"(t)); return t; }
__device__ __forceinline__ float silu_f(float g) { return g * __builtin_amdgcn_rcpf(1.f + __expf(-g)); }

namespace pg8 {
constexpr int BM = 256, BK = 64, HALF = 128, HTB = HALF * BK * 2, STAGE_BYTES = 8 * HTB, NXCD = 8, WGM = 4;
__host__ __device__ __forceinline__ int lds_byte(int r, int c) { const int st = (r >> 4) * 2 + (c >> 5), rr = r & 15, cc = c & 31, ob = rr * 64 + cc * 2; return st * 1024 + (ob ^ (((ob >> 9) & 1) << 5)); }
__host__ __device__ __forceinline__ void stage_rc(int b, int& R, int& C) { const int st = b / 1024, sb = b % 1024, swz = sb ^ (((sb >> 9) & 1) << 5); R = (st >> 1) * 16 + swz / 64; C = (st & 1) * 32 + (swz % 64) / 2; }
__host__ __device__ __forceinline__ int perm32(int rho) { const int n = rho >> 4, i = rho & 15; return 8 * (i >> 2) + 4 * n + (i & 3); }

struct Unit { int pm, pn; };
struct Gemm { const bf16_t* A; const bf16_t* Bt; int M, N; };

struct StaticOrder {
    int nM, nN, nwg, G, c;
    __device__ void init(int M, int N, int G_, int c_) { nM = M / BM; nN = N / BM; nwg = nM * nN; G = G_; c = c_; }
    __device__ bool next(int i, Unit& u) const {
        const long L = (long)i * G + c; if (L >= nwg) return false;
        int wgid = (int)L; { const int q = nwg / NXCD, r = nwg % NXCD, xcd = wgid % NXCD, off = wgid / NXCD; wgid = (xcd < r ? xcd * (q + 1) : r * (q + 1) + (xcd - r) * q) + off; }
        const int nig = WGM * nN, gid = wgid / nig, fm = gid * WGM, gsz = (nM - fm) < WGM ? (nM - fm) : WGM;
        u.pm = fm + ((wgid % nig) % gsz); u.pn = (wgid % nig) / gsz; return true;
    }
};

__device__ __forceinline__ unsigned cvt_pk_bf16(float lo, float hi) { unsigned r; asm volatile("v_cvt_pk_bf16_f32 %0, %1, %2" : "=v"(r) : "v"(lo), "v"(hi)); return r; }

struct EpiBf16 {
    static constexpr bool PERM = true;
    bf16_t* O; int ldc; int rope_tiles; const float* cosT; const float* sinT;
    __device__ __forceinline__ void init(f32x4 (&acc)[2][2][4][2], const Unit&, int, int, int, int) const {
#pragma unroll
        for (int a = 0; a < 2; ++a)
#pragma unroll
            for (int b = 0; b < 2; ++b)
#pragma unroll
                for (int m = 0; m < 4; ++m)
#pragma unroll
                    for (int n = 0; n < 2; ++n) acc[a][b][m][n] = (f32x4){0.f, 0.f, 0.f, 0.f};
    }
    __device__ __forceinline__ void operator()(f32x4 (&acc)[2][2][4][2], const Unit& u, int wr, int wc, int fr, int fq, LAS unsigned char*) const {
        const int row0 = u.pm * BM + wr * 64 + fr;
        if (u.pn < rope_tiles) {
            const float sc = u.pn >= 8 ? 0.0625f : 1.f;
            const int i0 = (wc & 1) * 32 + fq * 8; const int colb = u.pn * BM + (wc >> 1) * 128 + (wc & 1) * 32 + fq * 8;
#pragma unroll
            for (int ai = 0; ai < 2; ++ai)
#pragma unroll
                for (int m = 0; m < 4; ++m) { const int row = row0 + ai * HALF + m * 16; const int t = row & (SEQ - 1); const int pos = (wc >> 1) ? (t & 63) : (t >> 6);
                    const f32x4 c0 = *(const f32x4*)(cosT + pos * 64 + i0), c1 = *(const f32x4*)(cosT + pos * 64 + i0 + 4), s0 = *(const f32x4*)(sinT + pos * 64 + i0), s1 = *(const f32x4*)(sinT + pos * 64 + i0 + 4);
                    const f32x4 x0 = acc[ai][0][m][0], x1 = acc[ai][0][m][1], y0 = acc[ai][1][m][0], y1 = acc[ai][1][m][1];
                    const f32x4 xa0 = (x0 * c0 - y0 * s0) * sc, xa1 = (x1 * c1 - y1 * s1) * sc, yb0 = (y0 * c0 + x0 * s0) * sc, yb1 = (y1 * c1 + x1 * s1) * sc;
                    bf16_t* rowp = O + (size_t)row * ldc + colb;
                    u32x4 w; w.x = cvt_pk_bf16(xa0[0], xa0[1]); w.y = cvt_pk_bf16(xa0[2], xa0[3]); w.z = cvt_pk_bf16(xa1[0], xa1[1]); w.w = cvt_pk_bf16(xa1[2], xa1[3]);
                    *(u32x4*)(rowp) = w;
                    w.x = cvt_pk_bf16(yb0[0], yb0[1]); w.y = cvt_pk_bf16(yb0[2], yb0[3]); w.z = cvt_pk_bf16(yb1[0], yb1[1]); w.w = cvt_pk_bf16(yb1[2], yb1[3]);
                    *(u32x4*)(rowp + 64) = w;
                    if (m & 1) asm volatile("" ::: "memory"); }
            return;
        }
        const int col0 = u.pn * BM + wc * 32 + 8 * fq;
#pragma unroll
        for (int ai = 0; ai < 2; ++ai)
#pragma unroll
            for (int m = 0; m < 4; ++m) { bf16_t* rowp = O + (size_t)(row0 + ai * HALF + m * 16) * ldc + col0;
#pragma unroll
                for (int bj = 0; bj < 2; ++bj) { const f32x4 v0 = acc[ai][bj][m][0], v1 = acc[ai][bj][m][1];
                    u32x4 w; w.x = cvt_pk_bf16(v0[0], v0[1]); w.y = cvt_pk_bf16(v0[2], v0[3]); w.z = cvt_pk_bf16(v1[0], v1[1]); w.w = cvt_pk_bf16(v1[2], v1[3]);
                    *(u32x4*)(rowp + bj * HALF) = w; } }
    }
};
struct PanelOrder {
    int c;
    __device__ bool next(int i, Unit& u) const { if (i >= 2) return false; const int x = c & 7, q = c >> 3; u.pm = 32 * i + 4 * x + (q >> 3); u.pn = q & 7; return true; }
};
struct EpiLN {
    static constexpr bool PERM = false;
    const float* xin; float* out; bf16_t* xb; const float* gain; const float* bias; f32x2* xch; unsigned* cnt; float alpha; int write_xb;
    __device__ __forceinline__ void init(f32x4 (&acc)[2][2][4][2], const Unit& u, int wr, int wc, int fr, int fq) const {
        const int col0 = u.pn * BM + wc * 32 + 4 * fq;
#pragma unroll
        for (int ai = 0; ai < 2; ++ai)
#pragma unroll
            for (int m = 0; m < 4; ++m) { const size_t off = (size_t)(u.pm * BM + ai * HALF + wr * 64 + m * 16 + fr) * DM + col0;
#pragma unroll
                for (int bj = 0; bj < 2; ++bj)
#pragma unroll
                    for (int n = 0; n < 2; ++n) acc[ai][bj][m][n] = *(const f32x4*)(xin + off + bj * HALF + n * 16) * alpha; }
    }
    __device__ __forceinline__ void operator()(f32x4 (&acc)[2][2][4][2], const Unit& u, int wr, int wc, int fr, int fq, LAS unsigned char* lds) const {
        LAS f32x2* P = (LAS f32x2*)(lds + LDS_LN); LAS f32x2* ST = (LAS f32x2*)(lds + LDS_LN + 8192); LAS unsigned* flagw = (LAS unsigned*)(lds + LDS_LN + 8192 + 2048);
        const int tid = opaque_tid(), lane = tid & 63, wid = __builtin_amdgcn_readfirstlane(tid >> 6);
        const int col0 = u.pn * BM + wc * 32 + 4 * fq;
#pragma unroll
        for (int ai = 0; ai < 2; ++ai)
#pragma unroll
            for (int m = 0; m < 4; ++m) { float sv = 0.f, qv = 0.f;
#pragma unroll
                for (int bj = 0; bj < 2; ++bj)
#pragma unroll
                    for (int n = 0; n < 2; ++n) { const f32x4 x = acc[ai][bj][m][n]; sv += (x[0] + x[1]) + (x[2] + x[3]); qv += (x[0] * x[0] + x[1] * x[1]) + (x[2] * x[2] + x[3] * x[3]); }
                sv += __shfl_xor(sv, 16); sv += __shfl_xor(sv, 32); qv += __shfl_xor(qv, 16); qv += __shfl_xor(qv, 32);
                if (fq == 0) P[(ai * HALF + wr * 64 + m * 16 + fr) * 4 + wc] = (f32x2){sv, qv};
                __builtin_amdgcn_sched_barrier(0); }
        asm volatile("s_waitcnt lgkmcnt(0)" ::: "memory"); __builtin_amdgcn_s_barrier(); asm volatile("" ::: "memory");
        unsigned* pc = cnt + 16 * u.pm;
        if (tid < 256) { const f32x2 a = P[tid * 4 + 0], b = P[tid * 4 + 1], c = P[tid * 4 + 2], d = P[tid * 4 + 3];
            const float sv = (a.x + b.x) + (c.x + d.x), qv = (a.y + b.y) + (c.y + d.y);
            unsigned long long* slot = (unsigned long long*)xch + ((size_t)(u.pm * BM + tid) * 8 + u.pn);
            __hip_atomic_store(slot, ((unsigned long long)__float_as_uint(qv) << 32) | __float_as_uint(sv), __ATOMIC_RELAXED, __HIP_MEMORY_SCOPE_AGENT);
            asm volatile("s_waitcnt vmcnt(0)" ::: "memory");
            if (lane == 0) __hip_atomic_fetch_add(pc, 1u, __ATOMIC_RELAXED, __HIP_MEMORY_SCOPE_AGENT); }
        if (wid == 0) { unsigned sp = 0;
            while ((unsigned)__builtin_amdgcn_readfirstlane(__hip_atomic_load(pc, __ATOMIC_RELAXED, __HIP_MEMORY_SCOPE_AGENT)) < 32u) { __builtin_amdgcn_s_sleep(2); if (++sp > (1u << 20)) break; }
            __builtin_amdgcn_fence(__ATOMIC_ACQUIRE, "agent"); if (lane == 0) flagw[0] = sp; }
        asm volatile("s_waitcnt vmcnt(0) lgkmcnt(0)" ::: "memory"); __builtin_amdgcn_s_barrier(); asm volatile("" ::: "memory");
        if (tid < 256) { const unsigned long long* slot = (const unsigned long long*)xch + (size_t)(u.pm * BM + tid) * 8; float sv = 0.f, qv = 0.f;
#pragma unroll
            for (int t = 0; t < 8; ++t) { const unsigned long long w = __hip_atomic_load(slot + t, __ATOMIC_RELAXED, __HIP_MEMORY_SCOPE_AGENT); sv += __uint_as_float((unsigned)w); qv += __uint_as_float((unsigned)(w >> 32)); }
            const float mean = sv * (1.f / DM); const float var = fmaxf(qv * (1.f / DM) - mean * mean, 0.f);
            ST[tid] = (f32x2){mean, __builtin_amdgcn_rsqf(var + LN_EPS)}; }
        asm volatile("s_waitcnt lgkmcnt(0)" ::: "memory"); __builtin_amdgcn_s_barrier(); asm volatile("" ::: "memory");
#pragma unroll
        for (int ai = 0; ai < 2; ++ai)
#pragma unroll
            for (int m = 0; m < 4; ++m) { const int r = ai * HALF + wr * 64 + m * 16 + fr; const f32x2 sr = ST[r]; const size_t off = (size_t)(u.pm * BM + r) * DM + col0;
#pragma unroll
                for (int bj = 0; bj < 2; ++bj)
#pragma unroll
                    for (int n = 0; n < 2; ++n) { const f32x4 gn = *(const f32x4*)(gain + col0 + bj * HALF + n * 16), bs = *(const f32x4*)(bias + col0 + bj * HALF + n * 16);
                        const f32x4 o = (acc[ai][bj][m][n] - sr.x) * sr.y * gn + bs; *(f32x4*)(out + off + bj * HALF + n * 16) = o;
                        if (write_xb) { u32x2 w; w.x = cvt_pk_bf16(o[0], o[1]); w.y = cvt_pk_bf16(o[2], o[3]); *(u32x2*)(xb + off + bj * HALF + n * 16) = w; }
                        __builtin_amdgcn_sched_barrier(0); }
                asm volatile("" ::: "memory"); }
    }
};

template <class Epi, int K, int lda, class Sched = StaticOrder, bool ALIGN_EPI = true>
__device__ __forceinline__ void gemm_phase(LAS unsigned char* lds, const Gemm g, const Sched& S, const Epi& E) {
    const int tid = opaque_tid(), wid = __builtin_amdgcn_readfirstlane(tid >> 6), lane = tid & 63, wr = wid >> 2, wc = wid & 3, fr = lane & 15, fq = lane >> 4;
    constexpr int nt = K / BK;
    unsigned voffA[2], voffB[2];
#pragma unroll
    for (int i = 0; i < 2; ++i) { int R, C; stage_rc(tid * 16 + i * 8192, R, C); const int Rb = Epi::PERM ? ((R & ~31) + perm32(R & 31)) : R;
        voffA[i] = (unsigned)(R * lda + C) * 2u; voffB[i] = (unsigned)(Rb * K + C) * 2u; }
    constexpr size_t kstep = (size_t)(BK * 2);
    constexpr size_t hstepA = (size_t)HALF * lda * 2, hstepB = (size_t)HALF * K * 2;
    constexpr size_t tstepA = 2 * hstepA, tstepB = 2 * hstepB;
    const unsigned ldsw = (unsigned)wid * 1024u;
    const int aoff = lds_byte(wr * 64 + fr, fq * 8), boff = lds_byte(wc * 32 + fr, fq * 8);
#define PG8_SA(b, h) (((b) * 2 + (h)) * HTB)
#define PG8_SB(b, h) ((4 + (b) * 2 + (h)) * HTB)
#define PG8_STAGE(bufoff, gbase, voff) do { _Pragma("unroll") for (int _i = 0; _i < 2; ++_i) \
        __builtin_amdgcn_global_load_lds((const unsigned*)((const char*)(gbase) + (voff)[_i]), (LAS unsigned*)(lds + (bufoff) + ldsw + _i * 8192), 16, 0, 0); } while (0)
#define PG8_LDA(dst, b, h) do { _Pragma("unroll") for (int m = 0; m < 4; ++m) _Pragma("unroll") for (int k = 0; k < 2; ++k) dst[m][k] = *(const LAS bf16x8*)(lds + PG8_SA(b, h) + aoff + m * 2048 + k * 1024); } while (0)
#define PG8_LDB(dst, b, h) do { _Pragma("unroll") for (int n = 0; n < 2; ++n) _Pragma("unroll") for (int k = 0; k < 2; ++k) dst[n][k] = *(const LAS bf16x8*)(lds + PG8_SB(b, h) + boff + n * 2048 + k * 1024); } while (0)
#define PG8_MMA(ai, bj, At, Bt) do { __builtin_amdgcn_s_setprio(1); _Pragma("unroll") for (int m = 0; m < 4; ++m) _Pragma("unroll") for (int n = 0; n < 2; ++n) _Pragma("unroll") for (int k = 0; k < 2; ++k) \
        acc[ai][bj][m][n] = __builtin_amdgcn_mfma_f32_16x16x32_bf16(Bt[n][k], At[m][k], acc[ai][bj][m][n], 0, 0, 0); __builtin_amdgcn_s_setprio(0); } while (0)
#define PG8_WAIT_V(n) asm volatile("s_waitcnt vmcnt(" #n ")" ::: "memory")
#define PG8_WAIT_L(n) asm volatile("s_waitcnt lgkmcnt(" #n ")" ::: "memory")
#define PG8_BAR __builtin_amdgcn_s_barrier()
#define PG8_SCHED __builtin_amdgcn_sched_barrier(0)
    Unit cur, nxt; int ui = 0;
    if (!S.next(0, cur)) return;
    f32x4 acc[2][2][4][2];
    E.init(acc, cur, wr, wc, fr, fq);
    bf16x8 At[4][2], B0[2][2], B1[2][2];
    const char* cA = (const char*)g.A + (size_t)cur.pm * tstepA; const char* cB = (const char*)g.Bt + (size_t)cur.pn * tstepB;
    PG8_STAGE(PG8_SB(0, 0), cB, voffB); PG8_STAGE(PG8_SB(0, 1), cB + hstepB, voffB); PG8_STAGE(PG8_SA(0, 0), cA, voffA); PG8_STAGE(PG8_SA(0, 1), cA + hstepA, voffA);
    if (wr == 1) PG8_BAR;
    PG8_WAIT_V(2); PG8_BAR;
    PG8_STAGE(PG8_SB(1, 0), cB + kstep, voffB); PG8_STAGE(PG8_SA(1, 0), cA + kstep, voffA); PG8_STAGE(PG8_SB(1, 1), cB + hstepB + kstep, voffB);
    PG8_WAIT_V(6); PG8_BAR;
    for (;;) {
        const bool has_next = S.next(ui + 1, nxt);
        const char* nA = has_next ? (const char*)g.A + (size_t)nxt.pm * tstepA : cA; const char* nB = has_next ? (const char*)g.Bt + (size_t)nxt.pn * tstepB : cB;
        for (int t = 0; t < nt; t += 2) {
            const bool last = (t == nt - 2);
            const char* a1 = cA + (size_t)(t + 1) * kstep;
            const char* a2 = last ? nA : cA + (size_t)(t + 2) * kstep; const char* b2 = last ? nB : cB + (size_t)(t + 2) * kstep;
            const char* a3 = a2 + kstep; const char* b3 = b2 + kstep;
            PG8_LDB(B0, 0, 0); PG8_LDB(B1, 0, 1); PG8_SCHED; PG8_LDA(At, 0, 0); PG8_STAGE(PG8_SA(1, 1), a1 + hstepA, voffA);
            PG8_WAIT_V(8); PG8_WAIT_L(0); PG8_BAR; PG8_MMA(0, 0, At, B0); PG8_MMA(0, 1, At, B1); PG8_BAR; PG8_SCHED;
            PG8_LDA(At, 0, 1); PG8_STAGE(PG8_SB(0, 0), b2, voffB); PG8_STAGE(PG8_SB(0, 1), b2 + hstepB, voffB); PG8_STAGE(PG8_SA(0, 0), a2, voffA);
            PG8_WAIT_V(8); PG8_WAIT_L(0); PG8_BAR; PG8_MMA(1, 0, At, B0); PG8_MMA(1, 1, At, B1); PG8_BAR; PG8_SCHED;
            PG8_LDB(B0, 1, 0); PG8_LDB(B1, 1, 1); PG8_SCHED; PG8_LDA(At, 1, 0); PG8_STAGE(PG8_SA(0, 1), a2 + hstepA, voffA);
            PG8_WAIT_V(8); PG8_WAIT_L(0); PG8_BAR; PG8_MMA(0, 0, At, B0); PG8_MMA(0, 1, At, B1); PG8_BAR; PG8_SCHED;
            PG8_LDA(At, 1, 1); PG8_STAGE(PG8_SB(1, 0), b3, voffB); PG8_STAGE(PG8_SB(1, 1), b3 + hstepB, voffB); PG8_STAGE(PG8_SA(1, 0), a3, voffA);
            PG8_WAIT_V(8); PG8_WAIT_L(0); PG8_BAR; PG8_MMA(1, 0, At, B0); PG8_MMA(1, 1, At, B1); PG8_BAR; PG8_SCHED;
        }
        if constexpr (ALIGN_EPI) { if (wr == 0) PG8_BAR; }
        E(acc, cur, wr, wc, fr, fq, lds);
        if (!has_next) break;
        cur = nxt; cA = nA; cB = nB; ++ui;
        E.init(acc, cur, wr, wc, fr, fq);
        if constexpr (ALIGN_EPI) { if (wr == 1) PG8_BAR; }
    }
    PG8_WAIT_V(0);
    if constexpr (!ALIGN_EPI) { if (wr == 0) PG8_BAR; }
    PG8_BAR;
#undef PG8_SA
#undef PG8_SB
#undef PG8_STAGE
#undef PG8_LDA
#undef PG8_LDB
#undef PG8_MMA
#undef PG8_WAIT_V
#undef PG8_WAIT_L
#undef PG8_BAR
#undef PG8_SCHED
}
}

namespace att {
constexpr int D = 128, NW = 8, QBLK = 32, KVBLK = 64;
constexpr float SCALE = 0.088388347648318440f;
constexpr float THR = 8.f;
constexpr int LDQ = A_IN, LDK = A_IN, LDO = DM;
constexpr int SHM_V = KVBLK * D * 2, SHM_K = KVBLK * D * 2;
#define KSWZ(row, colB) ((row) * 256 + ((colB) ^ (((row) & 7) << 4)))
#define SBAR() __builtin_amdgcn_sched_barrier(0)
__device__ __forceinline__ int crow(int r, int hi) { return (r & 3) + 8 * (r >> 2) + 4 * hi; }
__device__ __forceinline__ unsigned cvtpk(float lo, float hi) { unsigned r; asm volatile("v_cvt_pk_bf16_f32 %0, %1, %2" : "=v"(r) : "v"(lo), "v"(hi)); return r; }
__device__ __forceinline__ bf16x8 ld8(const bf16_t* p) { return *reinterpret_cast<const bf16x8*>(p); }

__device__ __forceinline__ void partialSM(f32x16& p0, f32x16& p1, float& m_reg, float& mn, float& alpha) {
  constexpr float C = SCALE * 1.4426950408889634f;
  float pmax = p0[0]; for (int r = 1; r < 16; ++r) pmax = fmaxf(pmax, p0[r]); for (int r = 0; r < 16; ++r) pmax = fmaxf(pmax, p1[r]);
  { auto rr = __builtin_amdgcn_permlane32_swap(__float_as_uint(pmax), __float_as_uint(pmax), false, false);
    pmax = fmaxf(__uint_as_float(rr[0]), __uint_as_float(rr[1])); }
  if (__builtin_expect(__all(pmax - m_reg <= THR / SCALE), 1)) { mn = m_reg; alpha = 1.f; }
  else { mn = fmaxf(m_reg, pmax); alpha = __builtin_amdgcn_exp2f((m_reg - mn) * C); m_reg = mn; }
  float mnC = -mn * C;
  for (int r = 0; r < 16; ++r) p0[r] = fmaf(p0[r], C, mnC); for (int r = 0; r < 16; ++r) p1[r] = fmaf(p1[r], C, mnC);
  for (int r = 0; r < 16; ++r) p0[r] = __builtin_amdgcn_exp2f(p0[r]);
}
__device__ __forceinline__ void finishSM(f32x16& p0, f32x16& p1, float alpha, float& l_reg, bf16x8& pa0, bf16x8& pa1, bf16x8& pa2, bf16x8& pa3) {
  for (int r = 0; r < 16; ++r) p1[r] = __builtin_amdgcn_exp2f(p1[r]);
  float ps = 0; for (int r = 0; r < 16; ++r) ps += p0[r]; for (int r = 0; r < 16; ++r) ps += p1[r];
  { auto rr = __builtin_amdgcn_permlane32_swap(__float_as_uint(ps), __float_as_uint(ps), false, false);
    ps = __uint_as_float(rr[0]) + __uint_as_float(rr[1]); }
  l_reg = l_reg * alpha + ps;
#define PK4(P, BASE, OUT) do { unsigned a0 = cvtpk(P[BASE + 0], P[BASE + 1]), a1 = cvtpk(P[BASE + 2], P[BASE + 3]);   \
    unsigned b0 = cvtpk(P[BASE + 4], P[BASE + 5]), b1 = cvtpk(P[BASE + 6], P[BASE + 7]);                              \
    auto r0 = __builtin_amdgcn_permlane32_swap(a0, b0, false, false); auto r1 = __builtin_amdgcn_permlane32_swap(a1, b1, false, false); \
    u32x4 w = {r0[0], r1[0], r0[1], r1[1]}; OUT = *reinterpret_cast<bf16x8*>(&w); } while (0)
  PK4(p0, 0, pa0); PK4(p0, 8, pa1); PK4(p1, 0, pa2); PK4(p1, 8, pa3);
#undef PK4
}
__device__ __forceinline__ void qkt(f32x16& p0, f32x16& p1, const char* Ks, const bf16x8* qr, int r32, int hi) {
  p0 = f32x16{}; p1 = f32x16{};
  for (int d0 = 0; d0 < 8; ++d0) { int cb = (d0 * 16 + hi * 8) * 2;
    bf16x8 b0 = *reinterpret_cast<const bf16x8*>(Ks + KSWZ(r32, cb));
    bf16x8 b1 = *reinterpret_cast<const bf16x8*>(Ks + KSWZ(32 + r32, cb));
    p0 = __builtin_amdgcn_mfma_f32_32x32x16_bf16(b0, qr[d0], p0, 0, 0, 0);
    p1 = __builtin_amdgcn_mfma_f32_32x32x16_bf16(b1, qr[d0], p1, 0, 0, 0); }
}
__device__ __forceinline__ int v_st(int k, int c) { const int kk = (k & ~0xC) | ((k & 4) << 1) | ((k & 8) >> 1); return ((kk >> 3) * 4 + (c >> 5)) * 512 + ((kk & 7) * 32 + (c & 31)) * 2; }
__device__ __forceinline__ int v_rd_base(int lane) { return ((lane & 3) << 3) | (((lane >> 2) & 3) << 6) | (((lane >> 4) & 1) << 5) | (((lane >> 5) & 1) << 8); }
constexpr int v_rd_off(int d0, int ks, int half) { return d0 * 512 + ks * 4096 + half * 2048; }
template <int OFF> __device__ __forceinline__ s16x4 tr_read(int vb) {
  s16x4 r; asm volatile("ds_read_b64_tr_b16 %0, %1 offset:%2" : "=&v"(r) : "v"(vb), "i"(OFF) : "memory"); return r;
}
template <int D0> __device__ __forceinline__ void pv_one(f32x16& od, int vb, bf16x8 pa0, bf16x8 pa1, bf16x8 pa2, bf16x8 pa3) {
  const s16x4 l0 = tr_read<v_rd_off(D0, 0, 0)>(vb), h0 = tr_read<v_rd_off(D0, 0, 1)>(vb), l1 = tr_read<v_rd_off(D0, 1, 0)>(vb), h1 = tr_read<v_rd_off(D0, 1, 1)>(vb);
  const s16x4 l2 = tr_read<v_rd_off(D0, 2, 0)>(vb), h2 = tr_read<v_rd_off(D0, 2, 1)>(vb), l3 = tr_read<v_rd_off(D0, 3, 0)>(vb), h3 = tr_read<v_rd_off(D0, 3, 1)>(vb);
  asm volatile("s_waitcnt lgkmcnt(0)" ::: "memory"); SBAR();
#define PK(L, H) (bf16x8){L[0], L[1], L[2], L[3], H[0], H[1], H[2], H[3]}
  od = __builtin_amdgcn_mfma_f32_32x32x16_bf16(pa0, PK(l0, h0), od, 0, 0, 0);
  od = __builtin_amdgcn_mfma_f32_32x32x16_bf16(pa1, PK(l1, h1), od, 0, 0, 0);
  od = __builtin_amdgcn_mfma_f32_32x32x16_bf16(pa2, PK(l2, h2), od, 0, 0, 0);
  od = __builtin_amdgcn_mfma_f32_32x32x16_bf16(pa3, PK(l3, h3), od, 0, 0, 0);
#undef PK
}
__device__ __forceinline__ void pv_d0(f32x16* o, int vb, bf16x8 pa0, bf16x8 pa1, bf16x8 pa2, bf16x8 pa3) {
  pv_one<0>(o[0], vb, pa0, pa1, pa2, pa3); pv_one<1>(o[1], vb, pa0, pa1, pa2, pa3); pv_one<2>(o[2], vb, pa0, pa1, pa2, pa3); pv_one<3>(o[3], vb, pa0, pa1, pa2, pa3);
}
__device__ __forceinline__ void attn_body(const bf16_t* Qb, const bf16_t* Kh, const bf16_t* Vh, const bf16_t* Gb, bf16_t* Ob, int seq, char* lds,
                                          const float* qgain, const float* cosA, const float* sinA, int t0) {
  const int tid = opaque_tid(), wid = tid >> 6, lane = tid & 63, r32 = lane & 31, hi = lane >> 5;
  char* V_lds = lds; char* K_lds = lds + 2 * SHM_V;
  float* ws = (float*)(lds + 2 * SHM_V + 2 * SHM_K) + wid * 64; float* li_l = ws; float* al_l = ws + 32;
  float m_reg = -1e30f, l_reg = 0; f32x16 o[4] = {}; bf16x8 qr[8];
  const bf16_t* Qw = Qb + (long)(wid * QBLK + r32) * LDQ + hi * 8;
#pragma unroll
  for (int d0 = 0; d0 < 8; ++d0) qr[d0] = ld8(Qw + d0 * 16);
  {
    float ss = 0.f;
#pragma unroll
    for (int d0 = 0; d0 < 8; ++d0)
#pragma unroll
      for (int e = 0; e < 8; ++e) { const float v = bf2f((unsigned short)qr[d0][e]); ss += v * v; }
    { auto rr = __builtin_amdgcn_permlane32_swap(__float_as_uint(ss), __float_as_uint(ss), false, false); ss = __uint_as_float(rr[0]) + __uint_as_float(rr[1]); }
    const float rinv = __builtin_amdgcn_rsqf(ss * (1.f / 128) + RMS_EPS);
    const int t = t0 + wid * QBLK + r32, rp = t >> 6, cp = t & 63;
#pragma unroll
    for (int half = 0; half < 2; ++half) { const int pos = half ? cp : rp;
#pragma unroll
      for (int dd = 0; dd < 2; ++dd) { const int dx = 4 * half + dd, dy = dx + 2, i0 = 16 * dd + 8 * hi;
        const f32x4 c0 = *(const f32x4*)(cosA + pos * 32 + i0), c1 = *(const f32x4*)(cosA + pos * 32 + i0 + 4), s0 = *(const f32x4*)(sinA + pos * 32 + i0), s1 = *(const f32x4*)(sinA + pos * 32 + i0 + 4);
        const f32x4 gx0 = *(const f32x4*)(qgain + 16 * dx + 8 * hi), gx1 = *(const f32x4*)(qgain + 16 * dx + 8 * hi + 4), gy0 = *(const f32x4*)(qgain + 16 * dy + 8 * hi), gy1 = *(const f32x4*)(qgain + 16 * dy + 8 * hi + 4);
        float xo[8], yo[8];
#pragma unroll
        for (int e = 0; e < 8; ++e) { const float cc = e < 4 ? c0[e & 3] : c1[e & 3], sn = e < 4 ? s0[e & 3] : s1[e & 3];
          const float x = bf2f((unsigned short)qr[dx][e]) * rinv * (e < 4 ? gx0[e & 3] : gx1[e & 3]), y = bf2f((unsigned short)qr[dy][e]) * rinv * (e < 4 ? gy0[e & 3] : gy1[e & 3]);
          xo[e] = x * cc - y * sn; yo[e] = y * cc + x * sn; }
        u32x4 wx = {cvtpk(xo[0], xo[1]), cvtpk(xo[2], xo[3]), cvtpk(xo[4], xo[5]), cvtpk(xo[6], xo[7])}, wy = {cvtpk(yo[0], yo[1]), cvtpk(yo[2], yo[3]), cvtpk(yo[4], yo[5]), cvtpk(yo[6], yo[7])};
        qr[dx] = *reinterpret_cast<bf16x8*>(&wx); qr[dy] = *reinterpret_cast<bf16x8*>(&wy); } }
  }
  const int sr = tid >> 4, sc = (tid & 15) * 8, vst0 = v_st(sr, sc), vst1 = v_st(32 + sr, sc);
  const int vb0 = (int)(uintptr_t)V_lds + v_rd_base(lane);
  struct { bf16x8 vs0, vs1, ks0, ks1; } sr_[2];
#define SLOAD(i, k0) do { sr_[i].vs0 = ld8(&Vh[(long)((k0) + sr) * LDK + sc]); sr_[i].vs1 = ld8(&Vh[(long)((k0) + 32 + sr) * LDK + sc]); \
    sr_[i].ks0 = ld8(&Kh[(long)((k0) + sr) * LDK + sc]); sr_[i].ks1 = ld8(&Kh[(long)((k0) + 32 + sr) * LDK + sc]); } while (0)
#define SWRITE(b, i) do { *(bf16x8*)(V_lds + (b) * SHM_V + vst0) = sr_[i].vs0;          \
    *(bf16x8*)(V_lds + (b) * SHM_V + vst1) = sr_[i].vs1; int kc = sc * 2;               \
    *(bf16x8*)(K_lds + (b) * SHM_K + KSWZ(sr, kc)) = sr_[i].ks0;                       \
    *(bf16x8*)(K_lds + (b) * SHM_K + KSWZ(32 + sr, kc)) = sr_[i].ks1; } while (0)
#define SWAIT() asm volatile("s_waitcnt vmcnt(4)" ::: "memory")
#define RESC(a) do { if (__any((a) < 1.f)) { if (hi == 0) al_l[r32] = (a); asm volatile("s_waitcnt lgkmcnt(0)" ::: "memory"); \
    for (int d = 0; d < 4; ++d) for (int r = 0; r < 16; ++r) o[d][r] *= al_l[crow(r, hi)]; } } while (0)
  f32x16 pA0, pA1, pB0, pB1; float mnA, mnB, alA, alB; bf16x8 pa0, pa1, pa2, pa3; const int NT = seq / KVBLK;
  constexpr int SE = 0, SO = 1;
  SLOAD(SE, 0); asm volatile("s_waitcnt vmcnt(0)" ::: "memory"); SWRITE(0, SE); __syncthreads();
  qkt(pA0, pA1, K_lds, qr, r32, hi); partialSM(pA0, pA1, m_reg, mnA, alA);
  SLOAD(SO, KVBLK); if (2 < NT) SLOAD(SE, 2 * KVBLK);
  SWAIT(); SWRITE(1, SO); __syncthreads();
  for (int j = 1; j + 1 < NT; j += 2) {
    SBAR(); qkt(pB0, pB1, K_lds + SHM_K, qr, r32, hi);
    finishSM(pA0, pA1, alA, l_reg, pa0, pa1, pa2, pa3); SBAR();
    SLOAD(SO, (j + 2) * KVBLK); SBAR();
    pv_d0(o, vb0, pa0, pa1, pa2, pa3); partialSM(pB0, pB1, m_reg, mnB, alB);
    __syncthreads(); SWAIT(); SWRITE(0, SE);
    RESC(alB); __syncthreads();
    SBAR(); qkt(pA0, pA1, K_lds, qr, r32, hi);
    finishSM(pB0, pB1, alB, l_reg, pa0, pa1, pa2, pa3); SBAR();
    if (j + 3 < NT) SLOAD(SE, (j + 3) * KVBLK); SBAR();
    pv_d0(o, vb0 + (int)SHM_V, pa0, pa1, pa2, pa3); partialSM(pA0, pA1, m_reg, mnA, alA);
    __syncthreads(); SWAIT(); SWRITE(1, SO);
    RESC(alA); __syncthreads();
  }
  SBAR(); qkt(pB0, pB1, K_lds + SHM_K, qr, r32, hi);
  finishSM(pA0, pA1, alA, l_reg, pa0, pa1, pa2, pa3); SBAR();
  pv_d0(o, vb0, pa0, pa1, pa2, pa3); partialSM(pB0, pB1, m_reg, mnB, alB);
  __syncthreads(); RESC(alB);
  finishSM(pB0, pB1, alB, l_reg, pa0, pa1, pa2, pa3); SBAR();
  pv_d0(o, vb0 + (int)SHM_V, pa0, pa1, pa2, pa3);
  if (hi == 0) li_l[r32] = l_reg; asm volatile("s_waitcnt lgkmcnt(0)" ::: "memory");
  float rli[16];
#pragma unroll
  for (int r = 0; r < 16; ++r) rli[r] = __builtin_amdgcn_rcpf(li_l[crow(r, hi)]);
  __syncthreads();
  char* ot = lds + wid * 8704;
#pragma unroll
  for (int r = 0; r < 16; ++r) { const int orow = crow(r, hi);
#pragma unroll
    for (int d0 = 0; d0 < 4; ++d0) *(bf16_t*)(ot + orow * 272 + (d0 * 32 + r32) * 2) = (bf16_t)f2bf(o[d0][r] * rli[r]); }
  asm volatile("s_waitcnt lgkmcnt(0)" ::: "memory");
  bf16_t* Ow = Ob + (long)(wid * QBLK) * LDO; const bf16_t* Gw = Gb + (long)(wid * QBLK) * LDQ;
  u32x4 gq[8];
#pragma unroll
  for (int k = 0; k < 8; ++k) { const int pc = lane & 15, row = (lane >> 4) + 4 * k; gq[k] = *(const u32x4*)(Gw + (long)row * LDQ + pc * 8); }
#pragma unroll
  for (int k = 0; k < 8; ++k) { const int pc = lane & 15, row = (lane >> 4) + 4 * k; const u32x4 ov = *(const u32x4*)(ot + row * 272 + pc * 16); u32x4 w;
#pragma unroll
    for (int e = 0; e < 4; ++e) w[e] = cvtpk(bflo(ov[e]) * silu_f(bflo(gq[k][e])), bfhi(ov[e]) * silu_f(bfhi(gq[k][e])));
    *(u32x4*)(Ow + (long)row * LDO + pc * 8) = w; }
#undef SLOAD
#undef SWRITE
#undef SWAIT
#undef RESC
}
#undef KSWZ
#undef SBAR
}

namespace ret {
constexpr int CH = 64;
constexpr int RSQ = 576, RSV = 272, RSS = 144;
constexpr int QS = 0, KS = 36864, VS = 73728, SP = 91136, END = 100352;
__device__ __forceinline__ s16x4 trd(LAS unsigned char* p) { return __builtin_bit_cast(s16x4, __builtin_amdgcn_ds_read_tr16_b64_v4i16((LAS s16x4*)p)); }
__device__ __forceinline__ bf16x8 cat(s16x4 a, s16x4 b) { return (bf16x8){a[0], a[1], a[2], a[3], b[0], b[1], b[2], b[3]}; }
#define MF16(a, b, c) __builtin_amdgcn_mfma_f32_16x16x32_bf16((a), (b), (c), 0, 0, 0)
#define RBAR() do { asm volatile("s_waitcnt lgkmcnt(0)" ::: "memory"); __builtin_amdgcn_s_barrier(); asm volatile("" ::: "memory"); } while (0)
__device__ __forceinline__ unsigned cvtpk(float lo, float hi) { unsigned r; asm volatile("v_cvt_pk_bf16_f32 %0, %1, %2" : "=v"(r) : "v"(lo), "v"(hi)); return r; }
#define SCHED() __builtin_amdgcn_sched_barrier(0)
__device__ __forceinline__ void ret_item(LAS unsigned char* lds, const bf16_t* proj, bf16_t* OD, int b, int h, int dir, int vs, float lg2) {
    const int tid = opaque_tid(), wid = __builtin_amdgcn_readfirstlane(tid >> 6), lane = tid & 63, l15 = lane & 15, g = lane >> 4, q4 = l15 >> 2, pp = l15 & 3;
    const bf16_t* Qg = proj + (size_t)(b * SEQ) * R_IN + h * 256;
    const bf16_t* Kg = Qg + 2048;
    const bf16_t* Vg = proj + (size_t)(b * SEQ) * R_IN + 4096 + h * 512 + vs * 128;
    bf16_t* Og = OD + (size_t)(b * SEQ) * 4096 + h * 512 + vs * 128 + 16 * wid + 4 * g;
    f32x4 st[16];
#pragma unroll
    for (int i = 0; i < 16; ++i) st[i] = (f32x4){0.f, 0.f, 0.f, 0.f};
    const int qrow = tid >> 5, qpc = tid & 31, vrow = tid >> 4, vpc = tid & 15;
    bf16x8 pq[4], pk[4], pv[2];
    const float c16 = __builtin_amdgcn_exp2f(16.f * lg2), c32 = c16 * c16, c48 = c32 * c16, cd = c32 * c32;
    const float qdl = __builtin_amdgcn_exp2f((float)(dir ? 16 - l15 : l15 + 1) * lg2);
    float kd8[8], d4[4];
#pragma unroll
    for (int r = 0; r < 4; ++r) d4[r] = __builtin_amdgcn_exp2f((float)(dir ? 4 * g + r - l15 : l15 - 4 * g - r) * lg2);
#pragma unroll
    for (int jj = 0; jj < 8; ++jj) kd8[jj] = __builtin_amdgcn_exp2f((float)(dir ? 8 * g + jj : 31 - 8 * g - jj) * lg2);
    const int b3 = (l15 >> 3) & 1, sit = wid >> 1, sjt0 = 2 * (wid & 1), lo2 = 32 * (g & 1) + 8 * (g >> 1);
    LAS unsigned char* pSk = lds + KS + (16 * sjt0 + l15) * RSQ + ((16 * g) ^ (32 * b3));
    LAS unsigned char* pSq = lds + QS + (16 * sit + l15) * RSQ + (lo2 ^ (32 * b3));
    LAS unsigned char* pCq = lds + QS + l15 * RSQ + ((16 * g) ^ (32 * b3));
    LAS unsigned char* pIs = lds + SP + l15 * RSS + 16 * g;
    LAS unsigned char* pVt = lds + VS + (8 * g + q4) * RSV + (16 * wid + 4 * pp) * 2;
    LAS unsigned char* pKe = lds + KS + (8 * g + q4) * RSQ + 8 * pp + 32 * (g & 1);
    LAS unsigned char* pKo = lds + KS + (8 * g + q4) * RSQ + 8 * pp - 32 * (g & 1);
    const int sb3 = (qrow >> 3) & 1;
    LAS unsigned char* wQ = lds + QS + qrow * RSQ + ((16 * qpc) ^ (32 * sb3));
    LAS unsigned char* wK0 = lds + KS + qrow * RSQ + ((64 * (qpc >> 2) + 8 * (qpc & 3)) ^ (32 * sb3));
    LAS unsigned char* wK1 = lds + KS + qrow * RSQ + ((64 * (qpc >> 2) + 32 + 8 * (qpc & 3)) ^ (32 * sb3));
    {   const int c0 = dir ? 63 : 0; const size_t t0 = (size_t)c0 * CH;
#pragma unroll
        for (int k = 0; k < 4; ++k) { pq[k] = *(const bf16x8*)(Qg + (t0 + qrow + 16 * k) * R_IN + qpc * 8); pk[k] = *(const bf16x8*)(Kg + (t0 + qrow + 16 * k) * R_IN + qpc * 8); }
#pragma unroll
        for (int k = 0; k < 2; ++k) pv[k] = *(const bf16x8*)(Vg + (t0 + vrow + 32 * k) * R_IN + vpc * 8);
    }
#pragma unroll 1
    for (int step = 0; step < 64; ++step) {
        const int c = dir ? 63 - step : step; const size_t t0 = (size_t)c * CH;
#pragma unroll
        for (int k = 0; k < 4; ++k) { *(LAS bf16x8*)(wQ + 16 * k * RSQ) = pq[k];
            *(LAS s16x4*)(wK0 + 16 * k * RSQ) = (s16x4){pk[k][0], pk[k][1], pk[k][2], pk[k][3]}; *(LAS s16x4*)(wK1 + 16 * k * RSQ) = (s16x4){pk[k][4], pk[k][5], pk[k][6], pk[k][7]}; }
#pragma unroll
        for (int k = 0; k < 2; ++k) *(LAS bf16x8*)(lds + VS + (vrow + 32 * k) * RSV + vpc * 16) = pv[k];
        if (step + 1 < 64) { const int c1 = dir ? 62 - step : step + 1; const size_t t1 = (size_t)c1 * CH;
#pragma unroll
            for (int k = 0; k < 4; ++k) { pq[k] = *(const bf16x8*)(Qg + (t1 + qrow + 16 * k) * R_IN + qpc * 8); pk[k] = *(const bf16x8*)(Kg + (t1 + qrow + 16 * k) * R_IN + qpc * 8); }
#pragma unroll
            for (int k = 0; k < 2; ++k) pv[k] = *(const bf16x8*)(Vg + (t1 + vrow + 32 * k) * R_IN + vpc * 8);
        }
        RBAR();
        {   f32x4 sa0 = (f32x4){0.f, 0.f, 0.f, 0.f}, sa1 = sa0;
            s16x4 fq[2][2]; bf16x8 fk0[2], fk1[2];
#define LDS_S(buf, s) do { fq[buf][0] = *(const LAS s16x4*)(pSq + 64 * (s)); fq[buf][1] = *(const LAS s16x4*)(pSq + 64 * (s) + 16); fk0[buf] = *(const LAS bf16x8*)(pSk + 64 * (s)); fk1[buf] = *(const LAS bf16x8*)(pSk + 16 * RSQ + 64 * (s)); } while (0)
            LDS_S(0, 0);
#pragma unroll
            for (int s = 0; s < 8; ++s) { if (s < 7) LDS_S((s + 1) & 1, s + 1); SCHED();
                const bf16x8 bq = cat(fq[s & 1][0], fq[s & 1][1]);
                __builtin_amdgcn_s_setprio(1); sa0 = MF16(fk0[s & 1], bq, sa0); sa1 = MF16(fk1[s & 1], bq, sa1); __builtin_amdgcn_s_setprio(0); SCHED(); }
#undef LDS_S
#pragma unroll
            for (int tt = 0; tt < 2; ++tt) { const f32x4 sv = tt ? sa1 : sa0; const int dt = dir ? (sjt0 + tt - sit) : (sit - sjt0 - tt);
                const float cs = dt <= 0 ? 1.f : dt == 1 ? c16 : dt == 2 ? c32 : c48; float w[4];
#pragma unroll
                for (int r = 0; r < 4; ++r) { const bool on = dt > 0 || (dt == 0 && (dir ? (4 * g + r > l15) : (l15 >= 4 * g + r))); w[r] = on ? sv[r] * d4[r] * cs : 0.f; }
                u32x2 pkd; pkd.x = cvtpk(w[0], w[1]); pkd.y = cvtpk(w[2], w[3]);
                *(LAS u32x2*)(lds + SP + (16 * sit + l15) * RSS + (16 * (sjt0 + tt) + 4 * g) * 2) = pkd; }
        }
        RBAR();
        f32x4 acc[4];
#pragma unroll
        for (int it = 0; it < 4; ++it) acc[it] = (f32x4){0.f, 0.f, 0.f, 0.f};
        {   bf16x8 ca[2][4];
#define LDS_C(buf, s) do { _Pragma("unroll") for (int it = 0; it < 4; ++it) ca[buf][it] = *(const LAS bf16x8*)(pCq + 16 * it * RSQ + 64 * (s)); } while (0)
            LDS_C(0, 0);
#pragma unroll
            for (int s = 0; s < 8; ++s) { if (s < 7) LDS_C((s + 1) & 1, s + 1); SCHED();
                u32x4 bw; bw.x = cvtpk(st[2 * s][0], st[2 * s][1]); bw.y = cvtpk(st[2 * s][2], st[2 * s][3]); bw.z = cvtpk(st[2 * s + 1][0], st[2 * s + 1][1]); bw.w = cvtpk(st[2 * s + 1][2], st[2 * s + 1][3]);
                const bf16x8 bs = __builtin_bit_cast(bf16x8, bw);
                __builtin_amdgcn_s_setprio(1);
#pragma unroll
                for (int it = 0; it < 4; ++it) acc[it] = MF16(bs, ca[s & 1][it], acc[it]);
                __builtin_amdgcn_s_setprio(0); SCHED(); }
#undef LDS_C
        }
        bf16x8 bv[2], ia[2][4];
#pragma unroll
        for (int s = 0; s < 2; ++s) { bv[s] = cat(trd(pVt + 32 * s * RSV), trd(pVt + (32 * s + 4) * RSV));
#pragma unroll
            for (int it = 0; it < 4; ++it) ia[s][it] = *(const LAS bf16x8*)(pIs + 16 * it * RSS + 64 * s); }
        s16x4 ua[2][4][2];
#define LDS_U(buf, u) do { _Pragma("unroll") for (int k = 0; k < 4; ++k) { LAS unsigned char* pb = ((k & 1) ? pKo : pKe) + 32 * ((u) >> 2) * RSQ + 32 * (4 * ((u) & 3) + k); ua[buf][k][0] = trd(pb); ua[buf][k][1] = trd(pb + 4 * RSQ); } } while (0)
        LDS_U(0, 0);
        SCHED();
#pragma unroll
        for (int it = 0; it < 4; ++it) { const int ex = dir ? 3 - it : it; const float cq = qdl * (ex == 0 ? 1.f : ex == 1 ? c16 : ex == 2 ? c32 : c48); acc[it] = acc[it] * cq; }
#pragma unroll
        for (int s = 0; s < 2; ++s)
#pragma unroll
            for (int it = 0; it < 4; ++it) acc[it] = MF16(bv[s], ia[s][it], acc[it]);
        SCHED();
#pragma unroll
        for (int i = 0; i < 16; ++i) st[i] = st[i] * cd;
        bf16x8 bvd[2];
#pragma unroll
        for (int s = 0; s < 2; ++s) { const float ck = (dir ? s : 1 - s) ? c32 : 1.f; float e[8];
#pragma unroll
            for (int jj = 0; jj < 8; ++jj) e[jj] = bf2f((unsigned short)bv[s][jj]) * (kd8[jj] * ck);
            u32x4 bw; bw.x = cvtpk(e[0], e[1]); bw.y = cvtpk(e[2], e[3]); bw.z = cvtpk(e[4], e[5]); bw.w = cvtpk(e[6], e[7]);
            bvd[s] = __builtin_bit_cast(bf16x8, bw); }
#pragma unroll
        for (int u = 0; u < 8; ++u) { if (u < 7) LDS_U((u + 1) & 1, u + 1); SCHED();
            __builtin_amdgcn_s_setprio(1);
#pragma unroll
            for (int k = 0; k < 4; ++k) st[4 * (u & 3) + k] = MF16(cat(ua[u & 1][k][0], ua[u & 1][k][1]), bvd[u >> 2], st[4 * (u & 3) + k]);
            __builtin_amdgcn_s_setprio(0); SCHED(); }
#undef LDS_U
#pragma unroll
        for (int it = 0; it < 4; ++it) { u32x2 w; w.x = cvtpk(acc[it][0], acc[it][1]); w.y = cvtpk(acc[it][2], acc[it][3]); *(u32x2*)(Og + (t0 + 16 * it + l15) * 4096) = w; }
        RBAR();
    }
    asm volatile("s_waitcnt vmcnt(0) lgkmcnt(0)" ::: "memory"); __builtin_amdgcn_s_barrier();
}
#undef SCHED
#undef MF16
#undef RBAR
}

struct Params {
    const float* x; const float* a_win; const float* a_qg; const float* a_kg; const float* a_wout;
    const float* r_win; const float* r_dec; const float* r_wout; const float* ln_g; const float* ln_b;
    float* out; unsigned char* ws;
};

__device__ __forceinline__ void sincos_acc(float ang, float& c, float& s) {
    const double x = (double)ang;
    const double k = __builtin_rint(x * 0.6366197723675814);
    double r = __builtin_fma(-k, 1.5707963267948966, x);
    r = __builtin_fma(-k, 6.123233995736766e-17, r);
    const double r2 = r * r;
    const double sp = r * (1.0 + r2 * (-1.0 / 6 + r2 * (1.0 / 120 + r2 * (-1.0 / 5040 + r2 * (1.0 / 362880 + r2 * (-1.0 / 39916800 + r2 * (1.0 / 6227020800.0)))))));
    const double cp = 1.0 + r2 * (-0.5 + r2 * (1.0 / 24 + r2 * (-1.0 / 720 + r2 * (1.0 / 40320 + r2 * (-1.0 / 3628800 + r2 * (1.0 / 479001600 + r2 * (-1.0 / 87178291200.0)))))));
    const int q = ((int)k) & 3;
    const double sv = (q == 0) ? sp : (q == 1) ? cp : (q == 2) ? -sp : -cp;
    const double cv = (q == 0) ? cp : (q == 1) ? -sp : (q == 2) ? -cp : sp;
    c = (float)cv; s = (float)sv;
}
__device__ __forceinline__ void build_tables(const Params& p) {
    float* tab = (float*)(p.ws + WS_TAB);
    const int gt = blockIdx.x * 512 + opaque_tid();
    if (gt < 2048) {
        const int pos = gt >> 5, i = gt & 31; double f = 1.0; for (int k = 0; k < i; ++k) f *= 0.7498942093324559;
        const float ang = (float)pos * (float)f; float c, s; sincos_acc(ang, c, s); tab[gt] = c; tab[2048 + gt] = s;
    } else if (gt < 2048 + 4096) {
        const int t = gt - 2048; const int pos = t >> 6, i = t & 63; double f = 1.0; for (int k = 0; k < i; ++k) f *= 0.8659643233600653;
        const float ang = (float)pos * (float)f; float c, s; sincos_acc(ang, c, s); tab[4096 + t] = c; tab[8192 + t] = s;
    }
}
__device__ __forceinline__ void transpose_item(const float* W, int K, int N, bf16_t* WT, LAS float* scr, int item, int lane, int perm_cols) {
    const int nblk = N / 32, kb = item / nblk, nb = item % nblk, k0 = 64 * kb, n0 = 32 * nb;
#pragma unroll 8
    for (int i = 0; i < 32; ++i) { const int kk = 2 * i + (lane >> 5); scr[kk * 33 + (lane & 31)] = W[(size_t)(k0 + kk) * N + n0 + (lane & 31)]; }
    asm volatile("s_waitcnt lgkmcnt(0)" ::: "memory");
    const int c = lane & 7;
#pragma unroll
    for (int j = 0; j < 4; ++j) { const int n = (lane >> 3) + 8 * j; const LAS float* s = scr + (8 * c) * 33 + n;
        u32x4 o; o.x = pk2(s[0 * 33], s[1 * 33]); o.y = pk2(s[2 * 33], s[3 * 33]); o.z = pk2(s[4 * 33], s[5 * 33]); o.w = pk2(s[6 * 33], s[7 * 33]);
        int rowi = n0 + n;
        if (rowi < perm_cols) { const int oc = rowi & 255, part = oc >> 6, i6 = oc & 63; rowi = (rowi & ~255) + 128 * (part & 1) + 32 * (2 * (part >> 1) + (i6 >> 5)) + (i6 & 31); }
        *(u32x4*)(WT + (size_t)rowi * K + k0 + 8 * c) = o; }
    asm volatile("s_waitcnt lgkmcnt(0)" ::: "memory");
}
__device__ __forceinline__ void convert_weights(const Params& p, int L, LAS unsigned char* lds) {
    const int tid = opaque_tid(), lane = tid & 63, wave = __builtin_amdgcn_readfirstlane(tid >> 6), gw = blockIdx.x * 8 + wave, NGW = gridDim.x * 8;
    LAS float* scr = (LAS float*)(lds + wave * 16384);
    const int j = L >> 1;
    bf16_t* WinT = (bf16_t*)(p.ws + WS_WIN); bf16_t* WoutT = (bf16_t*)(p.ws + WS_WOUT + (size_t)(L & 1) * 16 * MiB);
    if (!(L & 1)) {
        const float* Win = p.a_win + (size_t)j * DM * A_IN; const float* Wout = p.a_wout + (size_t)j * DM * DM;
        constexpr int I_in = (DM / 64) * (A_IN / 32), I_out = (DM / 64) * (DM / 32);
        for (int it = gw; it < I_in + I_out; it += NGW) {
            if (it < I_in) transpose_item(Win, DM, A_IN, WinT, scr, it, lane, 0);
            else transpose_item(Wout, DM, DM, WoutT, scr, it - I_in, lane, 0);
        }
    } else {
        const float* Win = p.r_win + (size_t)j * DM * R_IN; const float* Wout = p.r_wout + (size_t)j * 4096 * DM;
        constexpr int I_in = (DM / 64) * (R_IN / 32), I_out = (4096 / 64) * (DM / 32);
        for (int it = gw; it < I_in + I_out; it += NGW) {
            if (it < I_in) transpose_item(Win, DM, R_IN, WinT, scr, it, lane, 4096);
            else transpose_item(Wout, 4096, DM, WoutT, scr, it - I_in, lane, 0);
        }
    }
}
__device__ __forceinline__ void ln_rows(const float* src, float* dst, bf16_t* xb, const float* gain, const float* bias, bool do_ln, bool write_xb) {
    const int tid = opaque_tid(), lane = tid & 63, wave = __builtin_amdgcn_readfirstlane(tid >> 6), gw = blockIdx.x * 8 + wave, NGW = gridDim.x * 8;
    for (int m0 = gw * 2; m0 < M_TOK; m0 += NGW * 2) {
        f32x4 v[2][8];
#pragma unroll
        for (int r = 0; r < 2; ++r) { const f32x4* xr = (const f32x4*)(src + (size_t)(m0 + r) * DM) + lane;
#pragma unroll
            for (int j = 0; j < 8; ++j) v[r][j] = xr[64 * j]; }
#pragma unroll
        for (int r = 0; r < 2; ++r) { const int m = m0 + r;
            if (do_ln) {
                float s = 0.f;
#pragma unroll
                for (int j = 0; j < 8; ++j) s += (v[r][j].x + v[r][j].y) + (v[r][j].z + v[r][j].w);
                const float mean = wave_sum(s) * (1.f / DM); float s2 = 0.f;
#pragma unroll
                for (int j = 0; j < 8; ++j) { v[r][j] = v[r][j] - mean; s2 += (v[r][j].x * v[r][j].x + v[r][j].y * v[r][j].y) + (v[r][j].z * v[r][j].z + v[r][j].w * v[r][j].w); }
                const float rstd = __builtin_amdgcn_rsqf(wave_sum(s2) * (1.f / DM) + LN_EPS);
#pragma unroll
                for (int j = 0; j < 8; ++j) { const f32x4 gn = ((const f32x4*)gain)[64 * j + lane], bs = ((const f32x4*)bias)[64 * j + lane]; v[r][j] = v[r][j] * rstd * gn + bs; }
                f32x4* orow = (f32x4*)(dst + (size_t)m * DM) + lane;
#pragma unroll
                for (int j = 0; j < 8; ++j) orow[64 * j] = v[r][j];
            }
            if (write_xb) {
                u32x2* o8 = (u32x2*)(xb + (size_t)m * DM) + lane;
#pragma unroll
                for (int j = 0; j < 8; ++j) { u32x2 w; w.x = pk2(v[r][j].x, v[r][j].y); w.y = pk2(v[r][j].z, v[r][j].w); o8[64 * j] = w; }
            }
        }
    }
}
__device__ __forceinline__ void prep_attn(const Params& p, int j) {
    const int tid = opaque_tid(), lane = tid & 63, wave = __builtin_amdgcn_readfirstlane(tid >> 6), gw = blockIdx.x * 8 + wave, NGW = gridDim.x * 8;
    bf16_t* proj = (bf16_t*)(p.ws + WS_PROJ); const float* tab = (const float*)(p.ws + WS_TAB);
    const float* cosA = tab; const float* sinA = tab + 2048;
    const int sub = lane & 15, part = sub >> 2, i0 = 8 * (sub & 3);
    const f32x4 g0 = *(const f32x4*)(p.a_kg + j * 128 + 8 * sub), g1 = *(const f32x4*)(p.a_kg + j * 128 + 8 * sub + 4);
    for (int m0 = gw * 4; m0 < M_TOK; m0 += NGW * 4) {
        u32x4 w[4];
#pragma unroll
        for (int r = 0; r < 4; ++r) w[r] = *((const u32x4*)(proj + (size_t)(m0 + r) * A_IN + 2048) + lane);
#pragma unroll
        for (int r = 0; r < 4; ++r) { const int m = m0 + r, t = m & (SEQ - 1), pos = part < 2 ? (t >> 6) : (t & 63);
            float x[8];
#pragma unroll
            for (int e = 0; e < 4; ++e) { x[2 * e] = bflo(w[r][e]); x[2 * e + 1] = bfhi(w[r][e]); }
            float ss = 0.f;
#pragma unroll
            for (int e = 0; e < 8; ++e) ss += x[e] * x[e];
            ss += __shfl_xor(ss, 1); ss += __shfl_xor(ss, 2); ss += __shfl_xor(ss, 4); ss += __shfl_xor(ss, 8);
            const float rinv = __builtin_amdgcn_rsqf(ss * (1.f / 128) + RMS_EPS);
#pragma unroll
            for (int e = 0; e < 8; ++e) x[e] *= rinv * (e < 4 ? g0[e & 3] : g1[e & 3]);
            const f32x4 c0 = *(const f32x4*)(cosA + pos * 32 + i0), c1 = *(const f32x4*)(cosA + pos * 32 + i0 + 4), s0 = *(const f32x4*)(sinA + pos * 32 + i0), s1 = *(const f32x4*)(sinA + pos * 32 + i0 + 4);
            float o[8];
#pragma unroll
            for (int e = 0; e < 8; ++e) { const float y = __shfl_xor(x[e], 4); const float cc = e < 4 ? c0[e & 3] : c1[e & 3], sn = e < 4 ? s0[e & 3] : s1[e & 3];
                o[e] = (part & 1) ? x[e] * cc + y * sn : x[e] * cc - y * sn; }
            u32x4 wo; wo.x = pk2(o[0], o[1]); wo.y = pk2(o[2], o[3]); wo.z = pk2(o[4], o[5]); wo.w = pk2(o[6], o[7]);
            *((u32x4*)(proj + (size_t)m * A_IN + 2048) + lane) = wo; }
    }
}
__device__ __forceinline__ void gn_gate(const Params& p) {
    const int tid = opaque_tid(), lane = tid & 63, wave = __builtin_amdgcn_readfirstlane(tid >> 6), gw = blockIdx.x * 8 + wave, NGW = gridDim.x * 8;
    bf16_t* proj = (bf16_t*)(p.ws + WS_PROJ); const bf16_t* OF = (const bf16_t*)(p.ws + WS_OF); const bf16_t* OBp = (const bf16_t*)(p.ws + WS_OB);
    for (int it = gw; it < M_TOK * 2; it += NGW) {
        const int m = it >> 1, h0 = 4 * (it & 1);
        u32x4 wf[4], wb[4], wg[4];
#pragma unroll
        for (int k = 0; k < 4; ++k) { wf[k] = *((const u32x4*)(OF + (size_t)m * 4096 + (h0 + k) * 512) + lane); wb[k] = *((const u32x4*)(OBp + (size_t)m * 4096 + (h0 + k) * 512) + lane);
            wg[k] = *((const u32x4*)(proj + (size_t)m * R_IN + 8192 + (h0 + k) * 512) + lane); }
#pragma unroll
        for (int k = 0; k < 4; ++k) {
            float o[8], gv[8];
#pragma unroll
            for (int e = 0; e < 4; ++e) { o[2 * e] = bflo(wf[k][e]) + bflo(wb[k][e]); o[2 * e + 1] = bfhi(wf[k][e]) + bfhi(wb[k][e]); gv[2 * e] = bflo(wg[k][e]); gv[2 * e + 1] = bfhi(wg[k][e]); }
            float s = 0.f;
#pragma unroll
            for (int e = 0; e < 8; ++e) s += o[e];
            const float mean = wave_sum(s) * (1.f / 512); float s2 = 0.f;
#pragma unroll
            for (int e = 0; e < 8; ++e) { o[e] -= mean; s2 += o[e] * o[e]; }
            const float rstd = __builtin_amdgcn_rsqf(wave_sum(s2) * (1.f / 512) + LN_EPS);
            u32x4 w;
#pragma unroll
            for (int e = 0; e < 4; ++e) w[e] = pk2(o[2 * e] * rstd * silu_f(gv[2 * e]), o[2 * e + 1] * rstd * silu_f(gv[2 * e + 1]));
            *((u32x4*)(proj + (size_t)m * R_IN + 8192 + (h0 + k) * 512) + lane) = w;
        }
    }
}

constexpr size_t WS_BAR = 1536 * 1024;
constexpr size_t WS_PCNT = WS_BAR + 16384;
#define XB_TMO      128
#define XB_XCNT(j)  (256  + 64 * (j))
#define XB_XSUB(j)  (1280 + 64 * (j))
#define XB_XGEN(j)  (2304 + 64 * (j))
#define XB_TOP      3328
#define XB_TOPGEN   3392
#define XCD_BAR_WORDS 3456
#define XB_SPIN_CAP (1u << 18)
__device__ __forceinline__ unsigned xb_ld(unsigned* p)              { return __hip_atomic_load(p, __ATOMIC_RELAXED, __HIP_MEMORY_SCOPE_AGENT); }
__device__ __forceinline__ unsigned xb_add(unsigned* p, unsigned v) { return __hip_atomic_fetch_add(p, v, __ATOMIC_RELAXED, __HIP_MEMORY_SCOPE_AGENT); }
__device__ __forceinline__ unsigned xb_xcc_id() { return (unsigned)__builtin_amdgcn_s_getreg((3 << 11) | 20) & 0xFu; }
#define XB_SPIN(cond, bar) do { unsigned _sp = 0; while (cond) { __builtin_amdgcn_s_sleep(1); \
    if ((++_sp & 255u) == 0u) { if (xb_ld(&(bar)[XB_TMO])) break; if (_sp > XB_SPIN_CAP) { atomicAdd(&(bar)[XB_TMO], 1u); break; } } } } while (0)
struct XcdBarrier { unsigned* bar; unsigned x; volatile LAS unsigned* st; };
__device__ __forceinline__ XcdBarrier xcd_barrier_post(unsigned* bar, volatile LAS unsigned* st) {
    XcdBarrier b; b.bar = bar; b.x = xb_xcc_id(); b.st = st;
    if (threadIdx.x == 0) (void)xb_add(&bar[XB_XCNT(b.x)], 1u);
    return b;
}
__device__ __forceinline__ void xcd_barrier_complete(unsigned* bar, unsigned x, unsigned& nloc, unsigned& nx) {
    const unsigned G = gridDim.x * gridDim.y * gridDim.z;
    unsigned sum, cnt, mine, sp = 0u;
    for (;;) {
        sum = 0u; cnt = 0u; mine = 0u;
#pragma unroll
        for (unsigned j = 0; j < 16; ++j) { const unsigned c = xb_ld(&bar[XB_XCNT(j)]); sum += c; cnt += (c > 0u) ? 1u : 0u; mine = (j == x) ? c : mine; }
        if (sum == G) break;
        __builtin_amdgcn_s_sleep(1);
        if ((++sp & 255u) == 0u) { if (xb_ld(&bar[XB_TMO])) break; if (sp > XB_SPIN_CAP) { atomicAdd(&bar[XB_TMO], 1u); break; } }
    }
    nloc = mine > 0u ? mine : 1u; nx = cnt > 0u ? cnt : 1u;
}
__device__ __forceinline__ void xcd_barrier(const XcdBarrier& b) {
    asm volatile("s_waitcnt vmcnt(0)" ::: "memory");
    __syncthreads();
    if (threadIdx.x == 0) {
        unsigned* bar = b.bar;
        __builtin_amdgcn_s_waitcnt(0);
        unsigned nloc = b.st[0], nx = b.st[1];
        if (nloc == 0u) { xcd_barrier_complete(bar, b.x, nloc, nx); b.st[0] = nloc; b.st[1] = nx; }
        const unsigned old = xb_add(&bar[XB_XSUB(b.x)], 1u);
        const unsigned gen = old / nloc;
        if (old + 1u == (gen + 1u) * nloc) {
            __builtin_amdgcn_fence(__ATOMIC_RELEASE, "agent");
            asm volatile("s_waitcnt vmcnt(0)" ::: "memory");
            const unsigned og = xb_add(&bar[XB_TOP], 1u);
            const unsigned tg = og / nx;
            if (og + 1u == (tg + 1u) * nx) xb_add(&bar[XB_TOPGEN], 1u);
            else XB_SPIN(xb_ld(&bar[XB_TOPGEN]) == tg, bar);
            __builtin_amdgcn_fence(__ATOMIC_ACQUIRE, "agent");
            xb_add(&bar[XB_XGEN(b.x)], 1u);
            asm volatile("s_waitcnt vmcnt(0)" ::: "memory");
        } else {
            XB_SPIN(xb_ld(&bar[XB_XGEN(b.x)]) == gen, bar);
            __builtin_amdgcn_fence(__ATOMIC_ACQUIRE, "agent");
            asm volatile("s_waitcnt vmcnt(0)" ::: "memory");
        }
    }
    __syncthreads();
}

__global__ void __launch_bounds__(512, 2) mega_fwd(Params p) {
    extern __shared__ __attribute__((aligned(16))) unsigned char lds_raw[];
    LAS unsigned char* lds = (LAS unsigned char*)lds_raw;
    cg::grid_group grid = cg::this_grid();
    const int G = gridDim.x, bx = blockIdx.x;
    bf16_t* proj = (bf16_t*)(p.ws + WS_PROJ); bf16_t* xb = (bf16_t*)(p.ws + WS_XB);
    bf16_t* WinT = (bf16_t*)(p.ws + WS_WIN); bf16_t* WoutT = (bf16_t*)(p.ws + WS_WOUT);
    bf16_t* OF = (bf16_t*)(p.ws + WS_OF); bf16_t* OB = (bf16_t*)(p.ws + WS_OB);

    {   unsigned* barw = (unsigned*)(p.ws + WS_BAR); const int t0 = opaque_tid();
        if (bx == 0) for (int i = t0; i < 4096 + 4096; i += 512) barw[i] = 0u;
        if (t0 < 2) ((volatile LAS unsigned*)(lds + 131072))[t0] = 0u; }
    build_tables(p);
    convert_weights(p, 0, lds);
    ln_rows(p.x, nullptr, xb, nullptr, nullptr, false, true);
    grid.sync();
    const XcdBarrier xbar = xcd_barrier_post((unsigned*)(p.ws + WS_BAR), (volatile LAS unsigned*)(lds + 131072));
#define GSYNC() xcd_barrier(xbar)

#pragma unroll 1
    for (int L = 0; L < 4; ++L) {
        const int j = L >> 1; const bool isA = !(L & 1);
        bf16_t* WoutL = (bf16_t*)(p.ws + WS_WOUT + (size_t)(L & 1) * 16 * MiB);
        {   pg8::Gemm g{xb, WinT, M_TOK, isA ? A_IN : R_IN}; pg8::StaticOrder S; S.init(M_TOK, g.N, G, bx);
            pg8::EpiBf16 E{proj, g.N, isA ? 0 : 16, (const float*)(p.ws + WS_TAB) + 4096, (const float*)(p.ws + WS_TAB) + 8192};
            pg8::gemm_phase<pg8::EpiBf16, DM, DM>(lds, g, S, E);
        }
        GSYNC();
        if (isA) {
            prep_attn(p, j);
            GSYNC();
            for (int u = bx; u < 1024; u += G) {
                const int b = u >> 8, w = u & 255, xcd = w & 7, slot = w >> 3, h = 2 * xcd + (slot >> 4), qb = slot & 15, kvh = h >> 2;
                const bf16_t* rowb = proj + (size_t)(b * SEQ) * A_IN;
                att::attn_body(rowb + (size_t)(qb * 256) * A_IN + h * 128, rowb + 2048 + kvh * 128, rowb + 2560 + kvh * 128,
                               rowb + (size_t)(qb * 256) * A_IN + 3072 + h * 128, OB + (size_t)(b * SEQ + qb * 256) * DM + h * 128, SEQ, (char*)lds_raw,
                               p.a_qg + j * 128, (const float*)(p.ws + WS_TAB), (const float*)(p.ws + WS_TAB) + 2048, qb * 256);
                __syncthreads();
            }
        } else {
            for (int u = bx; u < 256; u += G) {
                const int xcd = u & 7, slot = u >> 3, bh = xcd * 4 + (slot >> 3), sub = slot & 7, dir = sub >> 2, vs = sub & 3, b = bh >> 3, h = bh & 7;
                const float e = p.r_dec[j * 16 + dir * 8 + h]; const float xg = __builtin_amdgcn_exp2f(-e);
                const float lg = -(xg * (1.f + xg * (0.5f + xg * (1.f / 3 + xg * (0.25f + xg * (0.2f + xg * (1.f / 6)))))));
                ret::ret_item(lds, proj, dir ? OB : OF, b, h, dir, vs, lg * 1.4426950408889634f);
            }
            GSYNC();
            gn_gate(p);
        }
        GSYNC();
        const bool late_group = ((bx >> 6) & 1) != 0;
        if (L < 3 && late_group) { convert_weights(p, L + 1, lds); __syncthreads(); }
        {   pg8::EpiLN E{L == 0 ? p.x : p.out, p.out, xb, p.ln_g + L * DM, p.ln_b + L * DM, (f32x2*)(p.ws + WS_XCH), (unsigned*)(p.ws + WS_PCNT) + L * 1024, ALPHA, L < 3 ? 1 : 0};
            pg8::PanelOrder PO{bx};
            if (isA) { pg8::Gemm g{OB, WoutL, M_TOK, DM}; pg8::gemm_phase<pg8::EpiLN, DM, DM, pg8::PanelOrder>(lds, g, PO, E); }
            else { pg8::Gemm g{proj + 8192, WoutL, M_TOK, DM}; pg8::gemm_phase<pg8::EpiLN, 4096, R_IN, pg8::PanelOrder>(lds, g, PO, E); }
        }
        if (L < 3 && !late_group) convert_weights(p, L + 1, lds);
        if (L < 3) GSYNC();
    }
}

extern "C" void kernel_launch(void* const* d_in, const int* in_sizes, int n_in, void* d_out, int out_size, void* d_ws, size_t ws_size, hipStream_t stream) {
    static int grid_blocks = 0;
    if (grid_blocks == 0) {
        if (n_in != 10 || out_size != M_TOK * DM || ws_size < WS_END) { fprintf(stderr, "kernel_launch: unexpected shapes / workspace (n_in %d out %d ws %zu, need %zu)\n", n_in, out_size, ws_size, (size_t)WS_END); grid_blocks = -1; return; }
        int dev = 0, cus = 0, per_cu = 0;
        hipGetDevice(&dev);
        hipDeviceGetAttribute(&cus, hipDeviceAttributeMultiprocessorCount, dev);
        hipFuncSetAttribute((const void*)mega_fwd, hipFuncAttributeMaxDynamicSharedMemorySize, LDS_BYTES);
        hipOccupancyMaxActiveBlocksPerMultiprocessor(&per_cu, (const void*)mega_fwd, 512, LDS_BYTES);
        if (per_cu < 1) per_cu = 1;
        grid_blocks = cus * per_cu;
        if (grid_blocks > 256) grid_blocks = 256;
        if (grid_blocks != 256) { fprintf(stderr, "kernel_launch: this kernel needs a 256-workgroup grid (got %d)\n", grid_blocks); grid_blocks = -1; return; }
        (void)hipGetLastError();
    }
    if (grid_blocks < 0) return;
    Params p{};
    p.x = (const float*)d_in[0]; p.a_win = (const float*)d_in[1]; p.a_qg = (const float*)d_in[2]; p.a_kg = (const float*)d_in[3]; p.a_wout = (const float*)d_in[4];
    p.r_win = (const float*)d_in[5]; p.r_dec = (const float*)d_in[6]; p.r_wout = (const float*)d_in[7]; p.ln_g = (const float*)d_in[8]; p.ln_b = (const float*)d_in[9];
    p.out = (float*)d_out; p.ws = (unsigned char*)d_ws;
    void* args[] = {&p};
    hipError_t e = hipLaunchCooperativeKernel((const void*)mega_fwd, dim3(grid_blocks), dim3(512), args, LDS_BYTES, stream);
    if (e != hipSuccess) fprintf(stderr, "cooperative launch failed: %s (grid %d)\n", hipGetErrorString(e), grid_blocks);
}
```
